# Optimizing an MI355X kernel written in HIP

```python
import jax, jax.numpy as jnp
from jax import lax
import numpy as np

D_MODEL = 1024
BATCH = 4
SEQ = 8192
DEPTH = 2

CHUNK = 64
ATTN_HEADS = 16
ATTN_KV_HEADS = 4
ATTN_HEAD_DIM = 64
ATTN_GROUP = ATTN_HEADS // ATTN_KV_HEADS
WINDOW = 128
WIN_CHUNKS = WINDOW // CHUNK
BAND = (WIN_CHUNKS + 1) * CHUNK
ATTN_WIDTH = ATTN_HEADS * ATTN_HEAD_DIM
KV_WIDTH = ATTN_KV_HEADS * ATTN_HEAD_DIM
REC_EXPAND = 128
REC_HEADS = D_MODEL // REC_EXPAND
REC_KEY_DIM = REC_EXPAND
REC_VAL_DIM = D_MODEL // REC_HEADS
FORGET_DIM = REC_HEADS * REC_KEY_DIM
INPUT_DIM = REC_HEADS * REC_VAL_DIM
SPLIT_SIZES = (ATTN_WIDTH, KV_WIDTH, KV_WIDTH, FORGET_DIM, FORGET_DIM, INPUT_DIM, INPUT_DIM, D_MODEL, D_MODEL)
IN_WIDTH = sum(SPLIT_SIZES)
N_EXPERTS = 256
TOP_K = 8
N_GROUPS = 8
TOPK_GROUPS = 4
EXPERT_FF = 256
SHARED_FF = 256
ROUTED_SCALE = 2.5
EXPERT_BLOCK = 128
DEEPNORM_ALPHA = (2 * DEPTH) ** 0.25
DEEPNORM_BETA = (8 * DEPTH) ** -0.25
LN_EPS = 1e-5
RMS_EPS = 1e-5

kernel_name = "hybrid_swa_hgrn2_moe_deepnorm"


def layer_norm(x, g, b):
    xf = x.astype(jnp.float32)
    mu = jnp.mean(xf, axis=-1, keepdims=True)
    var = jnp.mean(jnp.square(xf - mu), axis=-1, keepdims=True)
    return ((xf - mu) * lax.rsqrt(var + LN_EPS) * g + b).astype(x.dtype)


def swiglu(x, w_gu, w_down):
    g, u = jnp.split(x @ w_gu, 2, axis=-1)
    return (jax.nn.silu(g) * u) @ w_down


def sliding_window_sink_attention(q, k, v, sinks):
    B, T = q.shape[0], q.shape[1]
    NC = T // CHUNK
    qc = q.reshape(B, NC, CHUNK, ATTN_KV_HEADS, ATTN_GROUP, ATTN_HEAD_DIM)

    def band(a):
        ac = a.reshape(B, NC, CHUNK, ATTN_KV_HEADS, ATTN_HEAD_DIM)
        ap = jnp.pad(ac, ((0, 0), (WIN_CHUNKS, 0), (0, 0), (0, 0), (0, 0)))
        return jnp.concatenate([ap[:, m:m + NC] for m in range(WIN_CHUNKS + 1)], axis=2)

    kb, vb = band(k), band(v)
    s = jnp.einsum('bnqhgd,bnshd->bhgnqs', qc, kb).astype(jnp.float32) * (ATTN_HEAD_DIM ** -0.5)
    key_chunk = jnp.arange(NC)[:, None] - WIN_CHUNKS + jnp.arange(BAND)[None, :] // CHUNK
    s = jnp.where((key_chunk >= 0)[:, None, :], s, -jnp.inf)
    sink = sinks.astype(jnp.float32).reshape(ATTN_KV_HEADS, ATTN_GROUP)[None, :, :, None, None, None]
    m = jnp.maximum(jnp.max(s, axis=-1, keepdims=True), sink)
    e = jnp.exp(s - m)
    p = e / (jnp.sum(e, axis=-1, keepdims=True) + jnp.exp(sink - m))
    o = jnp.einsum('bhgnqs,bnshd->bnqhgd', p.astype(v.dtype), vb)
    return o.reshape(B, T, ATTN_WIDTH)


def hgrn2_branch(q, f_logit, i, g, lower_bound, norm_g):
    B, T = q.shape[0], q.shape[1]
    NC = T // CHUNK
    f32 = jnp.float32
    lb = lower_bound.astype(f32).reshape(REC_HEADS, REC_KEY_DIM)
    fl = f_logit.astype(f32).reshape(B, T, REC_HEADS, REC_KEY_DIM)
    log_f = jnp.logaddexp(jnp.log(lb), jnp.log1p(-lb) + jax.nn.log_sigmoid(fl))
    k = -jnp.expm1(log_f)
    qh = jax.nn.silu(q.astype(f32)).reshape(B, T, REC_HEADS, REC_KEY_DIM)
    vh = i.astype(f32).reshape(B, T, REC_HEADS, REC_VAL_DIM)

    def chunks(a):
        return a.reshape(B, NC, CHUNK, REC_HEADS, a.shape[-1]).transpose(1, 0, 3, 2, 4)

    causal = jnp.tril(jnp.ones((CHUNK, CHUNK), dtype=bool))[:, :, None]

    def step(S, blk):
        qc, kc, vc, gc = blk
        b = jnp.cumsum(gc, axis=2)
        o_inter = jnp.einsum('bhtk,bhkv->bhtv', qc * jnp.exp(b), S)
        decay = jnp.exp(jnp.where(causal, b[:, :, :, None, :] - b[:, :, None, :, :], -jnp.inf))
        A = jnp.einsum('bhtk,bhtsk,bhsk->bhts', qc, decay, kc)
        o = o_inter + jnp.einsum('bhts,bhsv->bhtv', A, vc)
        b_end = b[:, :, -1:, :]
        S = jnp.exp(b_end[:, :, 0, :])[..., None] * S + jnp.einsum('bhsk,bhsv->bhkv', kc * jnp.exp(b_end - b), vc)
        return S, o

    S0 = jnp.zeros((B, REC_HEADS, REC_KEY_DIM, REC_VAL_DIM), f32)
    _, o = lax.scan(step, S0, (chunks(qh), chunks(k), chunks(vh), chunks(log_f)))
    o = o.transpose(1, 0, 3, 2, 4).reshape(B, T, REC_HEADS, REC_VAL_DIM)
    o = o * lax.rsqrt(jnp.mean(jnp.square(o), axis=-1, keepdims=True) + RMS_EPS) * norm_g
    o = o * jax.nn.silu(g.astype(f32).reshape(B, T, REC_HEADS, REC_VAL_DIM))
    return o.reshape(B, T, INPUT_DIM).astype(q.dtype)


def hybrid_mixer(h, w_in, b_in, sinks, rec_norm_g, lower_bound, w_proj_attn, w_proj_rec, w_out):
    B, T, _ = h.shape
    proj = jnp.einsum('btd,de->bte', h, w_in) + b_in
    offsets = np.cumsum(SPLIT_SIZES)[:-1].tolist()
    q_a, k_a, v_a, q_r, f_r, i_r, g_r, gate_a, gate_r = jnp.split(proj, offsets, axis=-1)
    attn = sliding_window_sink_attention(
        q_a.reshape(B, T, ATTN_HEADS, ATTN_HEAD_DIM),
        k_a.reshape(B, T, ATTN_KV_HEADS, ATTN_HEAD_DIM),
        v_a.reshape(B, T, ATTN_KV_HEADS, ATTN_HEAD_DIM), sinks)
    rec = hgrn2_branch(q_r, f_r, i_r, g_r, lower_bound, rec_norm_g)
    merged = jax.nn.sigmoid(gate_a) * (attn @ w_proj_attn) + jax.nn.sigmoid(gate_r) * (rec @ w_proj_rec)
    return merged @ w_out


def moe_ffn(h, router_w, router_bias, w_gu, w_down, sh_gu, sh_down):
    B, T, D = h.shape
    N = B * T
    f32 = jnp.float32
    hf = h.reshape(N, D)
    scores = jax.nn.sigmoid((hf @ router_w).astype(f32))
    sel = scores + router_bias.astype(f32)
    grp_score = lax.top_k(sel.reshape(N, N_GROUPS, N_EXPERTS // N_GROUPS), 2)[0].sum(-1)
    _, gidx = lax.top_k(grp_score, TOPK_GROUPS)
    gmask = jnp.any(gidx[:, :, None] == jnp.arange(N_GROUPS)[None, None, :], axis=1)
    sel = jnp.where(jnp.repeat(gmask, N_EXPERTS // N_GROUPS, axis=1), sel, -jnp.inf)
    _, idx = lax.top_k(sel, TOP_K)
    gate = jnp.take_along_axis(scores, idx, axis=1)
    gate = gate / jnp.sum(gate, axis=-1, keepdims=True) * ROUTED_SCALE
    R = N * TOP_K
    e_flat = idx.reshape(R)
    order = jnp.argsort(e_flat)
    e_sorted = e_flat[order]
    tok_sorted = (order // TOP_K).astype(jnp.int32)
    gate_sorted = gate.reshape(R)[order]
    counts = jnp.bincount(e_flat, length=N_EXPERTS)
    padded = (counts + EXPERT_BLOCK - 1) // EXPERT_BLOCK * EXPERT_BLOCK
    pad_end = jnp.cumsum(padded)
    pad_start = pad_end - padded
    start = jnp.cumsum(counts) - counts
    pos = pad_start[e_sorted] + jnp.arange(R) - start[e_sorted]
    n_blocks = -(-R // EXPERT_BLOCK) + N_EXPERTS
    rows = n_blocks * EXPERT_BLOCK
    row_tok = jnp.full((rows,), N, jnp.int32).at[pos].set(tok_sorted)
    row_gate = jnp.zeros((rows,), f32).at[pos].set(gate_sorted)
    blk_expert = jnp.minimum(jnp.searchsorted(pad_end, jnp.arange(n_blocks) * EXPERT_BLOCK, side='right'), N_EXPERTS - 1)
    h_pad = jnp.concatenate([hf, jnp.zeros((1, D), hf.dtype)], axis=0)

    def expert_block(acc, blk):
        toks, gw, e = blk
        yb = swiglu(h_pad[toks], w_gu[e], w_down[e])
        return acc.at[toks].add((yb * gw[:, None]).astype(acc.dtype)), None

    acc, _ = lax.scan(expert_block, jnp.zeros((N + 1, D), h.dtype),
                      (row_tok.reshape(n_blocks, EXPERT_BLOCK), row_gate.reshape(n_blocks, EXPERT_BLOCK), blk_expert))
    out = acc[:N] + swiglu(hf, sh_gu, sh_down)
    return out.reshape(B, T, D)


def setup_inputs(seed: int = 0) -> dict:
    key = jax.random.key(seed)
    ks = jax.random.split(key, 24)
    f32 = jnp.float32

    def nrm(k, shape, scale):
        return jax.random.normal(k, shape, f32) * scale

    L, D, E, F = DEPTH, D_MODEL, N_EXPERTS, EXPERT_FF
    return {
        "x": nrm(ks[0], (BATCH, SEQ, D), 1.0),
        "ln_in_g": 1.0 + nrm(ks[1], (D,), 0.05),
        "ln_in_b": nrm(ks[2], (D,), 0.02),
        "lb_logits": nrm(ks[3], (L, FORGET_DIM), 0.5),
        "w_in": nrm(ks[4], (L, D, IN_WIDTH), D ** -0.5),
        "b_in": nrm(ks[5], (L, IN_WIDTH), 0.02),
        "attn_sinks": nrm(ks[6], (L, ATTN_HEADS), 0.5),
        "rec_norm_g": 1.0 + nrm(ks[7], (L, REC_VAL_DIM), 0.05),
        "w_proj_attn": nrm(ks[8], (L, ATTN_WIDTH, D), ATTN_WIDTH ** -0.5 * DEEPNORM_BETA),
        "w_proj_rec": nrm(ks[9], (L, INPUT_DIM, D), INPUT_DIM ** -0.5 * DEEPNORM_BETA),
        "w_out": nrm(ks[10], (L, D, D), D ** -0.5 * DEEPNORM_BETA),
        "ln1_g": 1.0 + nrm(ks[11], (L, D), 0.05),
        "ln1_b": nrm(ks[12], (L, D), 0.02),
        "router_w": nrm(ks[13], (L, D, E), D ** -0.5),
        "router_bias": nrm(ks[14], (L, E), 0.01),
        "expert_w_gu": nrm(ks[15], (L, E, D, 2 * F), D ** -0.5),
        "expert_w_down": nrm(ks[16], (L, E, F, D), F ** -0.5 * DEEPNORM_BETA),
        "shared_w_gu": nrm(ks[17], (L, D, 2 * SHARED_FF), D ** -0.5),
        "shared_w_down": nrm(ks[18], (L, SHARED_FF, D), SHARED_FF ** -0.5 * DEEPNORM_BETA),
        "ln2_g": 1.0 + nrm(ks[19], (L, D), 0.05),
        "ln2_b": nrm(ks[20], (L, D), 0.02),
    }


def reference(x, ln_in_g, ln_in_b, lb_logits, w_in, b_in, attn_sinks, rec_norm_g, w_proj_attn, w_proj_rec,
              w_out, ln1_g, ln1_b, router_w, router_bias, expert_w_gu, expert_w_down, shared_w_gu,
              shared_w_down, ln2_g, ln2_b):
    p = jax.nn.softmax(lb_logits.astype(jnp.float32), axis=0)
    cum = jnp.cumsum(p, axis=0)
    lower_bounds = cum - cum[0:1]
    h = layer_norm(x, ln_in_g, ln_in_b)
    for l in range(DEPTH):
        y = hybrid_mixer(h, w_in[l], b_in[l], attn_sinks[l], rec_norm_g[l], lower_bounds[l],
                         w_proj_attn[l], w_proj_rec[l], w_out[l])
        h = layer_norm(DEEPNORM_ALPHA * h + y, ln1_g[l], ln1_b[l])
        y = moe_ffn(h, router_w[l], router_bias[l], expert_w_gu[l], expert_w_down[l],
                    shared_w_gu[l], shared_w_down[l])
        h = layer_norm(DEEPNORM_ALPHA * h + y, ln2_g[l], ln2_b[l])
    return h
```

```cpp
#include <hip/hip_runtime.h>
#include <cstdio>
#include <cstdint>

#define GAS __attribute__((address_space(1)))
#define LAS __attribute__((address_space(3)))
typedef unsigned short bf16;
typedef short bf16x8 __attribute__((ext_vector_type(8)));
typedef short s16x4 __attribute__((ext_vector_type(4)));
typedef float f32x4 __attribute__((ext_vector_type(4)));
typedef float f32x2 __attribute__((ext_vector_type(2)));
typedef float f32x16 __attribute__((ext_vector_type(16)));
typedef unsigned u32x4 __attribute__((ext_vector_type(4)));
typedef unsigned u32x2 __attribute__((ext_vector_type(2)));
typedef __bf16 bf16x2_t __attribute__((ext_vector_type(2)));
#define DI __device__ __forceinline__

DI unsigned pk2(float lo, float hi) { f32x2 v = {lo, hi}; return __builtin_bit_cast(unsigned, __builtin_convertvector(v, bf16x2_t)); }
DI float bflo(unsigned u) { return __uint_as_float(u << 16); }
DI float bfhi(unsigned u) { return __uint_as_float(u & 0xffff0000u); }
DI float bf2f(bf16 b) { return __uint_as_float((unsigned)b << 16); }
DI float fsigmoid(float x) { return __builtin_amdgcn_rcpf(1.f + __expf(-x)); }
DI float fsilu(float x) { return x * fsigmoid(x); }
DI unsigned char* opaque_ptr(unsigned char* p) { asm volatile("" : "+s"(p)); return p; }
DI int opaque_v(int v) { asm volatile("" : "+v"(v)); return v; }
DI int opaque_int(int v) { asm volatile("" : "+s"(v)); return v; }
DI float wave_sum(float v) {
#pragma unroll
    for (int o = 1; o < 64; o <<= 1) v += __shfl_xor(v, o);
    return v;
}

constexpr int NB = 4, SEQ = 8192, NTOK = NB * SEQ, DM = 1024, INW = 7680, NCHUNK = SEQ / 64;
constexpr int NE = 256, TOPK = 8, EFF = 256, RPAD_MAX = 1280 * 256;
constexpr float ALPHA = 1.4142135623730951f;
constexpr float LN_EPS = 1e-5f, RMS_EPS = 1e-5f;
constexpr int NWAVES = 8, NTHR = 512;

constexpr size_t MiB = 1u << 20;
constexpr size_t WS_CTL = 0, CTL_ZERO_BYTES = 1 * MiB;
constexpr size_t WS_WIN = 2 * MiB;
constexpr size_t WS_WPA = 34 * MiB;
constexpr size_t WS_WPR = 38 * MiB;
constexpr size_t WS_WOUT = 42 * MiB;
constexpr size_t WS_WRS = 46 * MiB;
constexpr size_t WS_WSD = 50 * MiB;
constexpr size_t WS_LB = 52 * MiB;
constexpr size_t WS_MISC = 53 * MiB;
constexpr size_t WS_WEGU = 64 * MiB;
constexpr size_t WS_WED = 576 * MiB;
constexpr size_t WS_H32 = 832 * MiB;
constexpr size_t WS_HB = 960 * MiB;
constexpr size_t WS_QA = 1024 * MiB, WS_KA = 1088 * MiB, WS_VA = 1104 * MiB, WS_QR = 1120 * MiB, WS_LF = 1184 * MiB, WS_IR = 1312 * MiB, WS_GR = 1376 * MiB, WS_GA = 1440 * MiB, WS_GT = 1504 * MiB;
constexpr size_t WS_ATT = 1568 * MiB, WS_REC = 1632 * MiB, WS_MRG = 1696 * MiB, WS_Y32 = 1760 * MiB;
constexpr size_t WS_RLOG = 1888 * MiB, WS_SACT = 1920 * MiB, WS_TIDX = 1936 * MiB, WS_TGATE = 1937 * MiB, WS_TPOS = 1938 * MiB, WS_ROWTOK = 1939 * MiB;
constexpr size_t WS_ACT = 1952 * MiB;
constexpr size_t WS_YS = 2112 * MiB;
constexpr size_t WS_END = 2752 * MiB;
constexpr int CW_BAR = 4096;
constexpr int CW_CNT = 16384;

constexpr int RING_BYTES = 131072;
constexpr int LDS_KEEP = 140 * 1024;
constexpr int MISC_OFF = 144 * 1024;
constexpr int LDS_BYTES = 147456;

namespace pg8 {
constexpr int BM = 256, BK = 64, HALF = 128, HTB = HALF * BK * 2, STAGE_BYTES = 8 * HTB, NXCD = 8, WGM = 8;
__host__ __device__ __forceinline__ int lds_byte(int r, int c) { const int st = (r >> 4) * 2 + (c >> 5), rr = r & 15, cc = c & 31, ob = rr * 64 + cc * 2; return st * 1024 + (ob ^ (((ob >> 9) & 1) << 5)); }
__host__ __device__ __forceinline__ void stage_rc(int b, int& R, int& C) { const int st = b / 1024, sb = b % 1024, swz = sb ^ (((sb >> 9) & 1) << 5); R = (st >> 1) * 16 + swz / 64; C = (st & 1) * 32 + (swz % 64) / 2; }
__host__ __device__ __forceinline__ int perm32(int rho) { const int n = rho >> 4, i = rho & 15; return 8 * (i >> 2) + 4 * n + (i & 3); }

struct Unit { int pm, pn, aux; };

DI bool static_unit(int i, int G, int c, int nM, int nN, Unit& u) {
    const int nwg = nM * nN; const long L = (long)i * G + c; if (L >= nwg) return false;
    int wgid = (int)L; { const int q = nwg / NXCD, r = nwg % NXCD, xcd = wgid % NXCD, off = wgid / NXCD; wgid = (xcd < r ? xcd * (q + 1) : r * (q + 1) + (xcd - r) * q) + off; }
    const int nig = WGM * nN, gid = wgid / nig, fm = gid * WGM, gsz = (nM - fm) < WGM ? (nM - fm) : WGM;
    u.pm = fm + ((wgid % nig) % gsz); u.pn = (wgid % nig) / gsz; u.aux = 0; return true;
}
struct DenseSched {
    const bf16* A; const bf16* Bt; int K, nM, nN, G, c;
    DI bool next(int i, Unit& u) const { return static_unit(i, G, c, nM, nN, u); }
    DI const char* a_base(const Unit& u) const { return (const char*)A + (size_t)u.pm * (size_t)(BM * K * 2); }
    DI const char* b_base(const Unit& u) const { return (const char*)Bt + (size_t)u.pn * (size_t)(BM * K * 2); }
    DI void a_offs(const Unit&, const int (&R)[2], const int (&C)[2], unsigned (&o)[2][2]) const {
#pragma unroll
        for (int h = 0; h < 2; ++h)
#pragma unroll
            for (int i = 0; i < 2; ++i) o[h][i] = (unsigned)((h * HALF + R[i]) * K + C[i]) * 2u;
    }
};
template <bool GATHER> struct GroupSched {
    const bf16* A; const bf16* Bt; const int* rowtok; const int* tile_e; int K, nM, nN, G, c; size_t bstride;
    DI bool next(int i, Unit& u) const { if (!static_unit(i, G, c, nM, nN, u)) return false; u.aux = __builtin_amdgcn_readfirstlane(tile_e[u.pm]); return true; }
    DI const char* a_base(const Unit& u) const { return GATHER ? (const char*)A : (const char*)A + (size_t)u.pm * (size_t)(BM * K * 2); }
    DI const char* b_base(const Unit& u) const { return (const char*)(Bt + (size_t)u.aux * bstride) + (size_t)u.pn * (size_t)(BM * K * 2); }
    DI void a_offs(const Unit& u, const int (&R)[2], const int (&C)[2], unsigned (&o)[2][2]) const {
#pragma unroll
        for (int h = 0; h < 2; ++h)
#pragma unroll
            for (int i = 0; i < 2; ++i) {
                if (GATHER) { const int tok = rowtok[u.pm * BM + h * HALF + R[i]]; o[h][i] = (unsigned)(tok * K + C[i]) * 2u; }
                else o[h][i] = (unsigned)((h * HALF + R[i]) * K + C[i]) * 2u;
            }
    }
};

template <class Epi, class Sched>
DI void gemm_phase(LAS unsigned char* lds, const Sched& S, const Epi& E) {
    const int tid = opaque_v(threadIdx.x), wid = __builtin_amdgcn_readfirstlane(tid >> 6), lane = tid & 63, wr = wid >> 2, wc = wid & 3, fr = lane & 15, fq = lane >> 4;
    const int K = S.K, nt = K / BK;
    int RR[2], CC[2]; unsigned voffB[2];
#pragma unroll
    for (int i = 0; i < 2; ++i) { int R, C; stage_rc(tid * 16 + i * 8192, R, C); const int Rb = (R & ~31) + perm32(R & 31); RR[i] = R; CC[i] = C; voffB[i] = (unsigned)(Rb * K + C) * 2u; }
    const size_t kstep = (size_t)(BK * 2);
    const size_t hstep = (size_t)HALF * K * 2;
    const unsigned ldsw = (unsigned)wid * 1024u;
    const int aoff = lds_byte(wr * 64 + fr, fq * 8), boff = lds_byte(wc * 32 + fr, fq * 8);
#define PG8_SA(b, h) (((b) * 2 + (h)) * HTB)
#define PG8_SB(b, h) ((4 + (b) * 2 + (h)) * HTB)
#define PG8_STAGE(bufoff, gbase, voff) do { _Pragma("unroll") for (int _i = 0; _i < 2; ++_i) \
        __builtin_amdgcn_global_load_lds((const unsigned*)((const char*)(gbase) + (voff)[_i]), (LAS unsigned*)(lds + (bufoff) + ldsw + _i * 8192), 16, 0, 0); } while (0)
#define PG8_LDA(dst, b, h) do { _Pragma("unroll") for (int m = 0; m < 4; ++m) _Pragma("unroll") for (int k = 0; k < 2; ++k) dst[m][k] = *(const LAS bf16x8*)(lds + PG8_SA(b, h) + aoff + m * 2048 + k * 1024); } while (0)
#define PG8_LDB(dst, b, h) do { _Pragma("unroll") for (int n = 0; n < 2; ++n) _Pragma("unroll") for (int k = 0; k < 2; ++k) dst[n][k] = *(const LAS bf16x8*)(lds + PG8_SB(b, h) + boff + n * 2048 + k * 1024); } while (0)
#define PG8_MMA(ai, bj, At, Bt) do { __builtin_amdgcn_s_setprio(1); _Pragma("unroll") for (int m = 0; m < 4; ++m) _Pragma("unroll") for (int n = 0; n < 2; ++n) _Pragma("unroll") for (int k = 0; k < 2; ++k) \
        acc[ai][bj][m][n] = __builtin_amdgcn_mfma_f32_16x16x32_bf16(Bt[n][k], At[m][k], acc[ai][bj][m][n], 0, 0, 0); __builtin_amdgcn_s_setprio(0); } while (0)
#define PG8_WAIT_V(n) asm volatile("s_waitcnt vmcnt(" #n ")" ::: "memory")
#define PG8_WAIT_L(n) asm volatile("s_waitcnt lgkmcnt(" #n ")" ::: "memory")
#define PG8_BAR __builtin_amdgcn_s_barrier()
#define PG8_SCHED __builtin_amdgcn_sched_barrier(0)
    Unit cur, nxt; int ui = 0;
    if (!S.next(0, cur)) return;
    f32x4 acc[2][2][4][2];
#pragma unroll
    for (int a = 0; a < 2; ++a)
#pragma unroll
        for (int b = 0; b < 2; ++b)
#pragma unroll
            for (int m = 0; m < 4; ++m)
#pragma unroll
                for (int n = 0; n < 2; ++n) acc[a][b][m][n] = (f32x4){0.f, 0.f, 0.f, 0.f};
    bf16x8 At[4][2], B0[2][2], B1[2][2];
    const char* cA = S.a_base(cur); const char* cB = S.b_base(cur);
    unsigned oAc[2][2], oAn[2][2];
    S.a_offs(cur, RR, CC, oAc);
    PG8_STAGE(PG8_SB(0, 0), cB, voffB); PG8_STAGE(PG8_SB(0, 1), cB + hstep, voffB); PG8_STAGE(PG8_SA(0, 0), cA, oAc[0]); PG8_STAGE(PG8_SA(0, 1), cA, oAc[1]);
    if (wr == 1) PG8_BAR;
    PG8_WAIT_V(2); PG8_BAR;
    PG8_STAGE(PG8_SB(1, 0), cB + kstep, voffB); PG8_STAGE(PG8_SA(1, 0), cA + kstep, oAc[0]); PG8_STAGE(PG8_SB(1, 1), cB + hstep + kstep, voffB);
    PG8_WAIT_V(6); PG8_BAR;
    for (;;) {
        const bool has_next = S.next(ui + 1, nxt);
        const char* nA = has_next ? S.a_base(nxt) : cA; const char* nB = has_next ? S.b_base(nxt) : cB;
        if (has_next) S.a_offs(nxt, RR, CC, oAn);
        else {
#pragma unroll
            for (int h = 0; h < 2; ++h)
#pragma unroll
                for (int i = 0; i < 2; ++i) oAn[h][i] = oAc[h][i]; }
        for (int t = 0; t < nt; t += 2) {
            const bool last = (t == nt - 2);
            const char* a1 = cA + (size_t)(t + 1) * kstep;
            const char* a2 = last ? nA : cA + (size_t)(t + 2) * kstep; const char* b2 = last ? nB : cB + (size_t)(t + 2) * kstep;
            const char* a3 = a2 + kstep; const char* b3 = b2 + kstep;
            unsigned o2[2][2];
#pragma unroll
            for (int h = 0; h < 2; ++h)
#pragma unroll
                for (int i = 0; i < 2; ++i) o2[h][i] = last ? oAn[h][i] : oAc[h][i];
            PG8_LDB(B0, 0, 0); PG8_LDB(B1, 0, 1); PG8_SCHED; PG8_LDA(At, 0, 0); PG8_STAGE(PG8_SA(1, 1), a1, oAc[1]);
            PG8_WAIT_V(8); PG8_WAIT_L(0); PG8_BAR; PG8_MMA(0, 0, At, B0); PG8_MMA(0, 1, At, B1); PG8_BAR; PG8_SCHED;
            PG8_LDA(At, 0, 1); PG8_STAGE(PG8_SB(0, 0), b2, voffB); PG8_STAGE(PG8_SB(0, 1), b2 + hstep, voffB); PG8_STAGE(PG8_SA(0, 0), a2, o2[0]);
            PG8_WAIT_V(8); PG8_WAIT_L(0); PG8_BAR; PG8_MMA(1, 0, At, B0); PG8_MMA(1, 1, At, B1); PG8_BAR; PG8_SCHED;
            PG8_LDB(B0, 1, 0); PG8_LDB(B1, 1, 1); PG8_SCHED; PG8_LDA(At, 1, 0); PG8_STAGE(PG8_SA(0, 1), a2, o2[1]);
            PG8_WAIT_V(8); PG8_WAIT_L(0); PG8_BAR; PG8_MMA(0, 0, At, B0); PG8_MMA(0, 1, At, B1); PG8_BAR; PG8_SCHED;
            PG8_LDA(At, 1, 1); PG8_STAGE(PG8_SB(1, 0), b3, voffB); PG8_STAGE(PG8_SB(1, 1), b3 + hstep, voffB); PG8_STAGE(PG8_SA(1, 0), a3, o2[0]);
            PG8_WAIT_V(8); PG8_WAIT_L(0); PG8_BAR; PG8_MMA(1, 0, At, B0); PG8_MMA(1, 1, At, B1); PG8_BAR; PG8_SCHED;
        }
        if (wr == 0) PG8_BAR;
        E(acc, cur, wr, wc, fr, fq);
        if (!has_next) break;
#pragma unroll
        for (int a = 0; a < 2; ++a)
#pragma unroll
            for (int b = 0; b < 2; ++b)
#pragma unroll
                for (int m = 0; m < 4; ++m)
#pragma unroll
                    for (int n = 0; n < 2; ++n) acc[a][b][m][n] = (f32x4){0.f, 0.f, 0.f, 0.f};
        cur = nxt; cA = nA; cB = nB; ++ui;
#pragma unroll
        for (int h = 0; h < 2; ++h)
#pragma unroll
            for (int i = 0; i < 2; ++i) oAc[h][i] = oAn[h][i];
        if (wr == 1) PG8_BAR;
    }
    PG8_WAIT_V(0);
    PG8_BAR;
#undef PG8_SA
#undef PG8_SB
#undef PG8_STAGE
#undef PG8_LDA
#undef PG8_LDB
#undef PG8_MMA
#undef PG8_WAIT_V
#undef PG8_WAIT_L
#undef PG8_BAR
#undef PG8_SCHED
}

#define EPI_ROWS_BEGIN  _Pragma("unroll") for (int ai = 0; ai < 2; ++ai) _Pragma("unroll") for (int m = 0; m < 4; ++m) { const int row = u.pm * BM + ai * HALF + wr * 64 + m * 16 + fr;
#define EPI_ROWS_END }

DI u32x4 pack8(f32x4 a, f32x4 b) { u32x4 w; w.x = pk2(a[0], a[1]); w.y = pk2(a[2], a[3]); w.z = pk2(b[0], b[1]); w.w = pk2(b[2], b[3]); return w; }

struct EpiInProj {
    unsigned char* ws; const float* bias; const float* lb;
    DI void operator()(const f32x4 (&acc)[2][2][4][2], const Unit& u, int wr, int wc, int fr, int fq) const {
        const int colt = u.pn * BM;
        int seg, cbase;
        if (colt < 1024) { seg = 0; cbase = colt; } else if (colt < 1280) { seg = 1; cbase = colt - 1024; } else if (colt < 1536) { seg = 2; cbase = colt - 1280; }
        else { seg = 3 + (colt - 1536) / 1024; cbase = (colt - 1536) % 1024; }
        size_t doff; int ld = 1024, act = 0;
        switch (seg) { case 0: doff = WS_QA; break; case 1: doff = WS_KA; ld = 256; break; case 2: doff = WS_VA; ld = 256; break; case 3: doff = WS_QR; act = 1; break;
                       case 4: doff = WS_LF; act = 3; break; case 5: doff = WS_IR; break; case 6: doff = WS_GR; act = 1; break; case 7: doff = WS_GA; act = 2; break; default: doff = WS_GT; act = 2; break; }
        bf16* dst = (bf16*)(ws + doff); float* lf = (float*)(ws + doff);
        const int cw = wc * 32 + 8 * fq;
        f32x4 bv[2][2], lbv[2][2];
#pragma unroll
        for (int bj = 0; bj < 2; ++bj)
#pragma unroll
            for (int n = 0; n < 2; ++n) { bv[bj][n] = *(const f32x4*)(bias + colt + bj * HALF + cw + 4 * n);
                lbv[bj][n] = (act == 3) ? *(const f32x4*)(lb + cbase + bj * HALF + cw + 4 * n) : (f32x4){0.f, 0.f, 0.f, 0.f}; }
        EPI_ROWS_BEGIN
#pragma unroll
            for (int bj = 0; bj < 2; ++bj) {
                f32x4 v[2] = {acc[ai][bj][m][0] + bv[bj][0], acc[ai][bj][m][1] + bv[bj][1]};
                const int c = cbase + bj * HALF + cw;
                if (act == 3) {
#pragma unroll
                    for (int n = 0; n < 2; ++n) {
#pragma unroll
                        for (int e = 0; e < 4; ++e) { const float x = v[n][e]; const float ls = fminf(x, 0.f) - __logf(1.f + __expf(-fabsf(x)));
                            const float l0 = lbv[bj][n][e]; v[n][e] = (l0 > 0.f) ? __logf(l0 + (1.f - l0) * __expf(ls)) : ls; }
                        *(f32x4*)(lf + (size_t)row * 1024 + c + 4 * n) = v[n]; }
                } else {
                    if (act == 1) {
#pragma unroll
                        for (int n = 0; n < 2; ++n)
#pragma unroll
                            for (int e = 0; e < 4; ++e) v[n][e] = fsilu(v[n][e]);
                    } else if (act == 2) {
#pragma unroll
                        for (int n = 0; n < 2; ++n)
#pragma unroll
                            for (int e = 0; e < 4; ++e) v[n][e] = fsigmoid(v[n][e]);
                    }
                    *(u32x4*)(dst + (size_t)row * ld + c) = pack8(v[0], v[1]);
                }
            }
        EPI_ROWS_END
    }
};
struct EpiF32 {
    float* O; int ld;
    DI void operator()(const f32x4 (&acc)[2][2][4][2], const Unit& u, int wr, int wc, int fr, int fq) const {
        const int c0 = u.pn * BM + wc * 32 + 8 * fq;
        EPI_ROWS_BEGIN
#pragma unroll
            for (int bj = 0; bj < 2; ++bj)
#pragma unroll
                for (int n = 0; n < 2; ++n) *(f32x4*)(O + (size_t)row * ld + c0 + bj * HALF + 4 * n) = acc[ai][bj][m][n];
        EPI_ROWS_END
    }
};
struct EpiBf16 {
    bf16* O; int ld;
    DI void operator()(const f32x4 (&acc)[2][2][4][2], const Unit& u, int wr, int wc, int fr, int fq) const {
        const int c0 = u.pn * BM + wc * 32 + 8 * fq;
        EPI_ROWS_BEGIN
#pragma unroll
            for (int bj = 0; bj < 2; ++bj) *(u32x4*)(O + (size_t)row * ld + c0 + bj * HALF) = pack8(acc[ai][bj][m][0], acc[ai][bj][m][1]);
        EPI_ROWS_END
    }
};
template <bool ADD> struct EpiGate {
    bf16* O; const bf16* gate;
    DI void operator()(const f32x4 (&acc)[2][2][4][2], const Unit& u, int wr, int wc, int fr, int fq) const {
        const int c0 = u.pn * BM + wc * 32 + 8 * fq;
        EPI_ROWS_BEGIN
#pragma unroll
            for (int bj = 0; bj < 2; ++bj) {
                const size_t off = (size_t)row * 1024 + c0 + bj * HALF;
                const u32x4 g = *(const u32x4*)(gate + off);
                f32x4 a = acc[ai][bj][m][0], b = acc[ai][bj][m][1];
                a[0] *= bflo(g.x); a[1] *= bfhi(g.x); a[2] *= bflo(g.y); a[3] *= bfhi(g.y); b[0] *= bflo(g.z); b[1] *= bfhi(g.z); b[2] *= bflo(g.w); b[3] *= bfhi(g.w);
                if (ADD) { const u32x4 o = *(const u32x4*)(O + off);
                    a[0] += bflo(o.x); a[1] += bfhi(o.x); a[2] += bflo(o.y); a[3] += bfhi(o.y); b[0] += bflo(o.z); b[1] += bfhi(o.z); b[2] += bflo(o.w); b[3] += bfhi(o.w); }
                *(u32x4*)(O + off) = pack8(a, b);
            }
        EPI_ROWS_END
    }
};
struct EpiSwiglu {
    bf16* O; int ld; int pn0;
    DI void operator()(const f32x4 (&acc)[2][2][4][2], const Unit& u, int wr, int wc, int fr, int fq) const {
        const int c0 = (u.pn - pn0) * HALF + wc * 32 + 8 * fq;
        EPI_ROWS_BEGIN
            f32x4 a, b;
#pragma unroll
            for (int e = 0; e < 4; ++e) { a[e] = fsilu(acc[ai][0][m][0][e]) * acc[ai][1][m][0][e]; b[e] = fsilu(acc[ai][0][m][1][e]) * acc[ai][1][m][1][e]; }
            *(u32x4*)(O + (size_t)row * ld + c0) = pack8(a, b);
        EPI_ROWS_END
    }
};
struct EpiRouterShared {
    float* rlog; bf16* sact;
    DI void operator()(const f32x4 (&acc)[2][2][4][2], const Unit& u, int wr, int wc, int fr, int fq) const {
        if (u.pn == 0) { EpiF32 e{rlog, 256}; e(acc, u, wr, wc, fr, fq); }
        else { EpiSwiglu e{sact, 256, 1}; e(acc, u, wr, wc, fr, fq); }
    }
};
}

#define XB_TMO      128
#define XB_XCNT(j)  (256  + 64 * (j))
#define XB_XSUB(j)  (1280 + 64 * (j))
#define XB_XGEN(j)  (2304 + 64 * (j))
#define XB_TOP      3328
#define XB_TOPGEN   3392
#define XCD_BAR_WORDS 3456
#define XB_SPIN_CAP (1u << 18)

__device__ __forceinline__ unsigned xb_ld(unsigned* p)              { return __hip_atomic_load(p, __ATOMIC_RELAXED, __HIP_MEMORY_SCOPE_AGENT); }
__device__ __forceinline__ unsigned xb_add(unsigned* p, unsigned v) { return __hip_atomic_fetch_add(p, v, __ATOMIC_RELAXED, __HIP_MEMORY_SCOPE_AGENT); }
__device__ __forceinline__ unsigned xb_xcc_id() { return (unsigned)__builtin_amdgcn_s_getreg((3 << 11) | 20) & 0xFu; }
#define XB_SPIN(cond, bar) do { unsigned _sp = 0; while (cond) { __builtin_amdgcn_s_sleep(1); \
    if ((++_sp & 255u) == 0u) { if (xb_ld(&(bar)[XB_TMO])) break; if (_sp > XB_SPIN_CAP) { atomicAdd(&(bar)[XB_TMO], 1u); break; } } } } while (0)

struct XcdBarrier { unsigned* bar; unsigned x; volatile LAS unsigned* st; };

__device__ __forceinline__ XcdBarrier xcd_barrier_post(unsigned* bar, volatile LAS unsigned* st) {
    XcdBarrier b; b.bar = bar; b.x = xb_xcc_id(); b.st = st;
    if (threadIdx.x == 0) (void)xb_add(&bar[XB_XCNT(b.x)], 1u);
    return b;
}
__device__ __forceinline__ void xcd_barrier_complete(unsigned* bar, unsigned x, unsigned& nloc, unsigned& nx) {
    const unsigned G = gridDim.x * gridDim.y * gridDim.z;
    unsigned sum, cnt, mine, sp = 0u;
    for (;;) {
        sum = 0u; cnt = 0u; mine = 0u;
#pragma unroll
        for (unsigned j = 0; j < 16; ++j) { const unsigned c = xb_ld(&bar[XB_XCNT(j)]); sum += c; cnt += (c > 0u) ? 1u : 0u; mine = (j == x) ? c : mine; }
        if (sum == G) break;
        __builtin_amdgcn_s_sleep(1);
        if ((++sp & 255u) == 0u) { if (xb_ld(&bar[XB_TMO])) break; if (sp > XB_SPIN_CAP) { atomicAdd(&bar[XB_TMO], 1u); break; } }
    }
    nloc = mine > 0u ? mine : 1u; nx = cnt > 0u ? cnt : 1u;
}
__device__ __forceinline__ void xcd_barrier(const XcdBarrier& b) {
    asm volatile("s_waitcnt vmcnt(0)" ::: "memory");
    __syncthreads();
    if (threadIdx.x == 0) {
        unsigned* bar = b.bar;
        __builtin_amdgcn_s_waitcnt(0);
        unsigned nloc = b.st[0], nx = b.st[1];
        if (nloc == 0u) { xcd_barrier_complete(bar, b.x, nloc, nx); b.st[0] = nloc; b.st[1] = nx; }
        const unsigned old = xb_add(&bar[XB_XSUB(b.x)], 1u);
        const unsigned gen = old / nloc;
        if (old + 1u == (gen + 1u) * nloc) {
            __builtin_amdgcn_fence(__ATOMIC_RELEASE, "agent");
            asm volatile("s_waitcnt vmcnt(0)" ::: "memory");
            const unsigned og = xb_add(&bar[XB_TOP], 1u);
            const unsigned tg = og / nx;
            if (og + 1u == (tg + 1u) * nx) xb_add(&bar[XB_TOPGEN], 1u);
            else XB_SPIN(xb_ld(&bar[XB_TOPGEN]) == tg, bar);
            __builtin_amdgcn_fence(__ATOMIC_ACQUIRE, "agent");
            xb_add(&bar[XB_XGEN(b.x)], 1u);
            asm volatile("s_waitcnt vmcnt(0)" ::: "memory");
        } else {
            XB_SPIN(xb_ld(&bar[XB_XGEN(b.x)]) == gen, bar);
            __builtin_amdgcn_fence(__ATOMIC_ACQUIRE, "agent");
            asm volatile("s_waitcnt vmcnt(0)" ::: "memory");
        }
    }
    __syncthreads();
}

struct Frame {
    LAS unsigned char* lds;
    int tid, lane, wave, vcu, G;
    unsigned char* ws;
};
struct Args { const float* in[21]; float* out; unsigned char* ws; int ph_lo, ph_hi; };
enum { I_X = 0, I_LNIN_G, I_LNIN_B, I_LB, I_WIN, I_BIN, I_SINK, I_RNG, I_WPA, I_WPR, I_WOUT, I_LN1G, I_LN1B, I_RW, I_RB, I_EGU, I_ED, I_SGU, I_SD, I_LN2G, I_LN2B };

DI void tr_item(const float* __restrict__ W, int ldw, int k0, int n0, bf16* dst, int ldd, int lane) {
    const float* src = W + (size_t)k0 * ldw + n0 + lane;
    bf16* d = dst + (size_t)lane * ldd;
#pragma unroll
    for (int kc = 0; kc < 8; ++kc) {
        float v[8];
#pragma unroll
        for (int j = 0; j < 8; ++j) v[j] = src[(size_t)(kc * 8 + j) * ldw];
        u32x4 o; o.x = pk2(v[0], v[1]); o.y = pk2(v[2], v[3]); o.z = pk2(v[4], v[5]); o.w = pk2(v[6], v[7]);
        *(u32x4*)(d + kc * 8) = o;
    }
}
DI int gu_row(int n) { const int j = n & 255, isu = n >> 8; return (j >> 7) * 256 + isu * 128 + (j & 127); }

DI void ln_row(f32x4 (&v)[4], const float* g, const float* b, float* o32, bf16* o16, int lane) {
    float s = 0.f;
#pragma unroll
    for (int j = 0; j < 4; ++j) s += (v[j][0] + v[j][1]) + (v[j][2] + v[j][3]);
    const float mean = wave_sum(s) * (1.f / DM); float s2 = 0.f;
#pragma unroll
    for (int j = 0; j < 4; ++j) { v[j] = v[j] - mean; s2 += (v[j][0] * v[j][0] + v[j][1] * v[j][1]) + (v[j][2] * v[j][2] + v[j][3] * v[j][3]); }
    const float rstd = 1.f / sqrtf(wave_sum(s2) * (1.f / DM) + LN_EPS);
#pragma unroll
    for (int j = 0; j < 4; ++j) {
        const f32x4 gg = *(const f32x4*)(g + 4 * lane + 256 * j), bb = *(const f32x4*)(b + 4 * lane + 256 * j);
        const f32x4 y = v[j] * rstd * gg + bb;
        if (o32) *(f32x4*)(o32 + 4 * lane + 256 * j) = y;
        if (o16) { u32x2 w; w.x = pk2(y[0], y[1]); w.y = pk2(y[2], y[3]); *(u32x2*)(o16 + 4 * lane + 256 * j) = w; }
    }
}

DI void prologue(Frame& F, const Args& A) {
    const int gw = F.vcu * NWAVES + F.wave, NGW = F.G * NWAVES, lane = F.lane;
    bf16* WIN = (bf16*)(F.ws + WS_WIN); bf16* WPA = (bf16*)(F.ws + WS_WPA); bf16* WPR = (bf16*)(F.ws + WS_WPR); bf16* WOUT = (bf16*)(F.ws + WS_WOUT);
    bf16* WRS = (bf16*)(F.ws + WS_WRS); bf16* WSD = (bf16*)(F.ws + WS_WSD); bf16* WEGU = (bf16*)(F.ws + WS_WEGU); bf16* WED = (bf16*)(F.ws + WS_WED);
    constexpr int N_GU = 512 * 128, N_ED = 512 * 64, N_SM = 2944, NITEMS = N_GU + N_ED + 2 * N_SM;
    for (int it0 = gw; it0 < NITEMS; it0 += NGW) {
        int it = it0;
        if (it < N_GU) { const int le = it >> 7, r = it & 127, kb = r >> 3, nb = r & 7, n0 = nb * 64;
            tr_item(A.in[I_EGU] + (size_t)le * (1024 * 512), 512, kb * 64, n0, WEGU + (size_t)le * (512 * 1024) + (size_t)gu_row(n0) * 1024 + kb * 64, 1024, lane); continue; }
        it -= N_GU;
        if (it < N_ED) { const int le = it >> 6, r = it & 63, kb = r >> 4, nb = r & 15, n0 = nb * 64;
            tr_item(A.in[I_ED] + (size_t)le * (256 * 1024), 1024, kb * 64, n0, WED + (size_t)le * (1024 * 256) + (size_t)n0 * 256 + kb * 64, 256, lane); continue; }
        it -= N_ED;
        const int l = it / N_SM; int r = it % N_SM;
        if (r < 1920) { const int kb = r / 120, nb = r % 120; tr_item(A.in[I_WIN] + (size_t)l * (1024 * INW), INW, kb * 64, nb * 64, WIN + (size_t)l * (INW * 1024) + (size_t)(nb * 64) * 1024 + kb * 64, 1024, lane); continue; }
        r -= 1920;
        if (r < 768) { const int w = r >> 8, q = r & 255, kb = q >> 4, nb = q & 15; const float* src = (w == 0 ? A.in[I_WPA] : (w == 1 ? A.in[I_WPR] : A.in[I_WOUT])) + (size_t)l * (1024 * 1024);
            bf16* dst = (w == 0 ? WPA : (w == 1 ? WPR : WOUT)) + (size_t)l * (1024 * 1024);
            tr_item(src, 1024, kb * 64, nb * 64, dst + (size_t)(nb * 64) * 1024 + kb * 64, 1024, lane); continue; }
        r -= 768;
        if (r < 64) { const int kb = r >> 2, nb = r & 3; tr_item(A.in[I_RW] + (size_t)l * (1024 * 256), 256, kb * 64, nb * 64, WRS + (size_t)l * (768 * 1024) + (size_t)(nb * 64) * 1024 + kb * 64, 1024, lane); continue; }
        r -= 64;
        if (r < 128) { const int kb = r >> 3, nb = r & 7, n0 = nb * 64; tr_item(A.in[I_SGU] + (size_t)l * (1024 * 512), 512, kb * 64, n0, WRS + (size_t)l * (768 * 1024) + (size_t)(256 + gu_row(n0)) * 1024 + kb * 64, 1024, lane); continue; }
        r -= 128;
        { const int kb = r >> 4, nb = r & 15; tr_item(A.in[I_SD] + (size_t)l * (256 * 1024), 1024, kb * 64, nb * 64, WSD + (size_t)l * (1024 * 256) + (size_t)(nb * 64) * 256 + kb * 64, 256, lane); }
    }
    float* H32 = (float*)(F.ws + WS_H32); bf16* HB = (bf16*)(F.ws + WS_HB);
    for (int m = gw; m < NTOK; m += NGW) {
        f32x4 v[4];
#pragma unroll
        for (int j = 0; j < 4; ++j) v[j] = *(const f32x4*)(A.in[I_X] + (size_t)m * DM + 4 * lane + 256 * j);
        ln_row(v, A.in[I_LNIN_G], A.in[I_LNIN_B], H32 + (size_t)m * DM, HB + (size_t)m * DM, lane);
    }
    float* LB = (float*)(F.ws + WS_LB);
    for (int i = blockIdx.x * NTHR + F.tid; i < 1024; i += F.G * NTHR) {
        const float a = A.in[I_LB][i], b = A.in[I_LB][1024 + i], mx = fmaxf(a, b), ea = __expf(a - mx), eb = __expf(b - mx);
        LB[i] = 0.f; LB[1024 + i] = eb / (ea + eb);
    }
    int* ROWTOK = (int*)(F.ws + WS_ROWTOK);
    for (int i = blockIdx.x * NTHR + F.tid; i < RPAD_MAX; i += F.G * NTHR) ROWTOK[i] = 0;
}

constexpr int ATT_VP = 196;
DI int crow(int reg, int h) { return (reg & 3) + 8 * (reg >> 2) + 4 * h; }
DI void attn_unit(Frame& F, int b, int c, int hk, const float* sinks) {
    const bf16* QA = (const bf16*)(F.ws + WS_QA); const bf16* KA = (const bf16*)(F.ws + WS_KA); const bf16* VA = (const bf16*)(F.ws + WS_VA); bf16* ATT = (bf16*)(F.ws + WS_ATT);
    LAS bf16* VT = (LAS bf16*)F.lds;
    const int lane = F.lane, w = F.wave, r = lane & 31, h = lane >> 5;
    const int nkc = (c < 2 ? c : 2) + 1, nkeys = nkc * 64, ktok0 = b * SEQ + (c - (nkc - 1)) * 64;
    __syncthreads();
    for (int ch = F.tid; ch < nkeys * 8; ch += NTHR) {
        const int key = ch >> 3, d0 = (ch & 7) * 8;
        const u32x4 v = *(const u32x4*)(VA + (size_t)(ktok0 + key) * 256 + hk * 64 + d0);
        const unsigned vv[4] = {v.x, v.y, v.z, v.w};
#pragma unroll
        for (int j = 0; j < 4; ++j) { VT[(d0 + 2 * j) * ATT_VP + key] = (bf16)(vv[j] & 0xffffu); VT[(d0 + 2 * j + 1) * ATT_VP + key] = (bf16)(vv[j] >> 16); }
    }
    __syncthreads();
    const int head = hk * 4 + (w >> 1), qtok = b * SEQ + c * 64 + (w & 1) * 32 + r;
    bf16x8 qf[4];
#pragma unroll
    for (int ks = 0; ks < 4; ++ks) qf[ks] = *(const bf16x8*)(QA + (size_t)qtok * 1024 + head * 64 + ks * 16 + 8 * h);
    f32x16 s[6];
#pragma unroll
    for (int kt = 0; kt < 6; ++kt) {
#pragma unroll
        for (int i = 0; i < 16; ++i) s[kt][i] = 0.f;
        if (kt < nkc * 2) {
#pragma unroll
            for (int ks = 0; ks < 4; ++ks) {
                const bf16x8 kf = *(const bf16x8*)(KA + (size_t)(ktok0 + kt * 32 + r) * 256 + hk * 64 + ks * 16 + 8 * h);
                s[kt] = __builtin_amdgcn_mfma_f32_32x32x16_bf16(kf, qf[ks], s[kt], 0, 0, 0);
            }
        }
    }
    const float sink = sinks[head];
    float mx = -INFINITY;
#pragma unroll
    for (int kt = 0; kt < 6; ++kt) if (kt < nkc * 2) {
#pragma unroll
        for (int i = 0; i < 16; ++i) mx = fmaxf(mx, s[kt][i]);
    }
    mx = fmaxf(mx, __shfl_xor(mx, 32));
    mx = fmaxf(mx * 0.125f, sink);
    float sum = 0.f;
#pragma unroll
    for (int kt = 0; kt < 6; ++kt) if (kt < nkc * 2) {
#pragma unroll
        for (int i = 0; i < 16; ++i) { const float p = __expf(s[kt][i] * 0.125f - mx); s[kt][i] = p; sum += p; }
    }
    sum += __shfl_xor(sum, 32);
    const float inv = 1.f / (sum + __expf(sink - mx));
    f32x16 o[2];
#pragma unroll
    for (int dt = 0; dt < 2; ++dt)
#pragma unroll
        for (int i = 0; i < 16; ++i) o[dt][i] = 0.f;
#pragma unroll
    for (int kt = 0; kt < 6; ++kt) if (kt < nkc * 2) {
#pragma unroll
        for (int st = 0; st < 2; ++st) {
            u32x4 pw; pw.x = pk2(s[kt][8 * st + 0], s[kt][8 * st + 1]); pw.y = pk2(s[kt][8 * st + 2], s[kt][8 * st + 3]); pw.z = pk2(s[kt][8 * st + 4], s[kt][8 * st + 5]); pw.w = pk2(s[kt][8 * st + 6], s[kt][8 * st + 7]);
            const bf16x8 ps = __builtin_bit_cast(bf16x8, pw);
#pragma unroll
            for (int dt = 0; dt < 2; ++dt) {
                const LAS bf16* vp = VT + (dt * 32 + r) * ATT_VP + kt * 32 + 16 * st + 4 * h;
                const s16x4 lo = *(const LAS s16x4*)vp, hi = *(const LAS s16x4*)(vp + 8);
                const bf16x8 vf = __builtin_shufflevector(lo, hi, 0, 1, 2, 3, 4, 5, 6, 7);
                o[dt] = __builtin_amdgcn_mfma_f32_32x32x16_bf16(vf, ps, o[dt], 0, 0, 0);
            }
        }
    }
    bf16* orow = ATT + (size_t)qtok * 1024 + head * 64;
#pragma unroll
    for (int dt = 0; dt < 2; ++dt)
#pragma unroll
        for (int g = 0; g < 4; ++g) { u32x2 wv; wv.x = pk2(o[dt][4 * g] * inv, o[dt][4 * g + 1] * inv); wv.y = pk2(o[dt][4 * g + 2] * inv, o[dt][4 * g + 3] * inv);
            *(u32x2*)(orow + dt * 32 + 8 * g + 4 * h) = wv; }
}

constexpr int HP = 136, HS = 72;
constexpr int HL_Q1 = 0, HL_Q2 = HL_Q1 + 64 * HP * 2, HL_K2 = HL_Q2 + 64 * HP * 2, HL_K3T = HL_K2 + 64 * HP * 2, HL_VT = HL_K3T + 128 * HS * 2, HL_A = HL_VT + 128 * HS * 2,
              HL_S = HL_A + 64 * HS * 2, HL_DEC = HL_S + 128 * HP * 2, HL_SSQ = HL_DEC + 512, HL_END = HL_SSQ + 1024;
static_assert(HL_END <= LDS_KEEP, "hgrn LDS");
DI bf16x8 lds_frag(const LAS bf16* p) { return *(const LAS bf16x8*)p; }
DI void hgrn_unit(Frame& F, int b, int hh, const float* rng) {
    const bf16* QR = (const bf16*)(F.ws + WS_QR); const float* LF = (const float*)(F.ws + WS_LF); const bf16* IR = (const bf16*)(F.ws + WS_IR); const bf16* GR = (const bf16*)(F.ws + WS_GR);
    bf16* REC = (bf16*)(F.ws + WS_REC);
    LAS bf16* Q1 = (LAS bf16*)(F.lds + HL_Q1); LAS bf16* Q2 = (LAS bf16*)(F.lds + HL_Q2); LAS bf16* K2 = (LAS bf16*)(F.lds + HL_K2); LAS bf16* K3T = (LAS bf16*)(F.lds + HL_K3T);
    LAS bf16* VT = (LAS bf16*)(F.lds + HL_VT); LAS bf16* AL = (LAS bf16*)(F.lds + HL_A); LAS bf16* SL = (LAS bf16*)(F.lds + HL_S);
    LAS float* DEC = (LAS float*)(F.lds + HL_DEC); LAS float* SSQ = (LAS float*)(F.lds + HL_SSQ);
    const int lane = F.lane, w = F.wave, r = lane & 31, h = lane >> 5, tid = F.tid;
    const int tg = lane >> 3, cp = lane & 7, ch0 = 16 * w + 2 * cp;
    const int kt = w >> 1, vt0 = 2 * (w & 1);
    const int ovt = w & 3, ott = w >> 2;
    f32x16 S0, S1;
#pragma unroll
    for (int i = 0; i < 16; ++i) { S0[i] = 0.f; S1[i] = 0.f; }
    __syncthreads();
    for (int i = tid; i < 128 * HP / 2; i += NTHR) ((LAS unsigned*)SL)[i] = 0u;
    float ng[16];
#pragma unroll
    for (int i = 0; i < 16; ++i) ng[i] = rng[ovt * 32 + crow(i, h)];
    for (int c = 0; c < NCHUNK; ++c) {
        const size_t tok0 = (size_t)b * SEQ + (size_t)c * 64;
        {
            f32x2 lf[8]; unsigned qv[8], vv[8];
#pragma unroll
            for (int j = 0; j < 8; ++j) { const size_t o = (tok0 + 8 * tg + j) * 1024 + hh * 128 + ch0;
                lf[j] = *(const f32x2*)(LF + o); qv[j] = *(const unsigned*)(QR + o); vv[j] = *(const unsigned*)(IR + o); }
            f32x2 bcum[8]; f32x2 run = {0.f, 0.f};
#pragma unroll
            for (int j = 0; j < 8; ++j) { run = run + lf[j]; bcum[j] = run; }
            f32x2 incl = run;
#pragma unroll
            for (int d = 8; d < 64; d <<= 1) { const float u0 = __shfl_up(incl[0], d), u1 = __shfl_up(incl[1], d); if (lane >= d) { incl[0] += u0; incl[1] += u1; } }
            const f32x2 excl = incl - run;
            f32x2 bend, bmid; bend[0] = __shfl(incl[0], 56 + cp); bend[1] = __shfl(incl[1], 56 + cp); bmid[0] = __shfl(incl[0], 24 + cp); bmid[1] = __shfl(incl[1], 24 + cp);
            unsigned k3a[4], k3b[4]; float k3p[2];
#pragma unroll
            for (int j = 0; j < 8; ++j) {
                const f32x2 bb = bcum[j] + excl;
                const float q0 = bflo(qv[j]), q1 = bfhi(qv[j]);
                const float kk0 = 1.f - __expf(lf[j][0]), kk1 = 1.f - __expf(lf[j][1]);
                const int t = 8 * tg + j;
                *(LAS unsigned*)(Q1 + t * HP + ch0) = pk2(q0 * __expf(bb[0]), q1 * __expf(bb[1]));
                *(LAS unsigned*)(Q2 + t * HP + ch0) = pk2(q0 * __expf(bb[0] - bmid[0]), q1 * __expf(bb[1] - bmid[1]));
                *(LAS unsigned*)(K2 + t * HP + ch0) = pk2(kk0 * __expf(bmid[0] - bb[0]), kk1 * __expf(bmid[1] - bb[1]));
                const float e0 = kk0 * __expf(bend[0] - bb[0]), e1 = kk1 * __expf(bend[1] - bb[1]);
                if (j & 1) { k3a[j >> 1] = pk2(k3p[0], e0); k3b[j >> 1] = pk2(k3p[1], e1); } else { k3p[0] = e0; k3p[1] = e1; }
            }
            *(LAS u32x4*)(K3T + ch0 * HS + 8 * tg) = (u32x4){k3a[0], k3a[1], k3a[2], k3a[3]};
            *(LAS u32x4*)(K3T + (ch0 + 1) * HS + 8 * tg) = (u32x4){k3b[0], k3b[1], k3b[2], k3b[3]};
            u32x4 va, vb;
            va.x = (vv[0] & 0xffffu) | (vv[1] << 16); va.y = (vv[2] & 0xffffu) | (vv[3] << 16); va.z = (vv[4] & 0xffffu) | (vv[5] << 16); va.w = (vv[6] & 0xffffu) | (vv[7] << 16);
            vb.x = (vv[0] >> 16) | (vv[1] & 0xffff0000u); vb.y = (vv[2] >> 16) | (vv[3] & 0xffff0000u); vb.z = (vv[4] >> 16) | (vv[5] & 0xffff0000u); vb.w = (vv[6] >> 16) | (vv[7] & 0xffff0000u);
            *(LAS u32x4*)(VT + ch0 * HS + 8 * tg) = va;
            *(LAS u32x4*)(VT + (ch0 + 1) * HS + 8 * tg) = vb;
            if (tg == 0) { DEC[ch0] = __expf(bend[0]); DEC[ch0 + 1] = __expf(bend[1]); }
        }
        __syncthreads();
        if (w < 3) {
            const int stl = (w == 2) ? 1 : 0, ttl = (w == 0) ? 0 : 1;
            f32x16 a;
#pragma unroll
            for (int i = 0; i < 16; ++i) a[i] = 0.f;
#pragma unroll
            for (int ks = 0; ks < 8; ++ks) {
                const bf16x8 af = lds_frag(K2 + (stl * 32 + r) * HP + ks * 16 + 8 * h), bf = lds_frag(Q2 + (ttl * 32 + r) * HP + ks * 16 + 8 * h);
                a = __builtin_amdgcn_mfma_f32_32x32x16_bf16(af, bf, a, 0, 0, 0);
            }
            const int t = ttl * 32 + r;
#pragma unroll
            for (int g = 0; g < 4; ++g) {
                float x[4];
#pragma unroll
                for (int e = 0; e < 4; ++e) { const int s = stl * 32 + 8 * g + 4 * h + e; x[e] = (s <= t) ? a[4 * g + e] : 0.f; }
                u32x2 wv; wv.x = pk2(x[0], x[1]); wv.y = pk2(x[2], x[3]);
                *(LAS u32x2*)(AL + t * HS + stl * 32 + 8 * g + 4 * h) = wv;
            }
        }
        __syncthreads();
        f32x16 o;
#pragma unroll
        for (int i = 0; i < 16; ++i) o[i] = 0.f;
#pragma unroll
        for (int ks = 0; ks < 8; ++ks) {
            const bf16x8 af = lds_frag(SL + (ovt * 32 + r) * HP + ks * 16 + 8 * h), bf = lds_frag(Q1 + (ott * 32 + r) * HP + ks * 16 + 8 * h);
            o = __builtin_amdgcn_mfma_f32_32x32x16_bf16(af, bf, o, 0, 0, 0);
        }
#pragma unroll
        for (int ks = 0; ks < 4; ++ks) if (ks < 2 * (ott + 1)) {
            const bf16x8 af = lds_frag(VT + (ovt * 32 + r) * HS + ks * 16 + 8 * h), bf = lds_frag(AL + (ott * 32 + r) * HS + ks * 16 + 8 * h);
            o = __builtin_amdgcn_mfma_f32_32x32x16_bf16(af, bf, o, 0, 0, 0);
        }
        {
            float ss = 0.f;
#pragma unroll
            for (int i = 0; i < 16; ++i) ss += o[i] * o[i];
            ss += __shfl_xor(ss, 32);
            if (h == 0) SSQ[ovt * 64 + ott * 32 + r] = ss;
        }
        __syncthreads();
        {
#pragma unroll
            for (int i = 0; i < 16; ++i) { const float d = DEC[kt * 32 + crow(i, h)]; S0[i] *= d; S1[i] *= d; }
#pragma unroll
            for (int ks = 0; ks < 4; ++ks) {
                const bf16x8 af = lds_frag(K3T + (kt * 32 + r) * HS + ks * 16 + 8 * h);
                const bf16x8 b0 = lds_frag(VT + (vt0 * 32 + r) * HS + ks * 16 + 8 * h), b1 = lds_frag(VT + ((vt0 + 1) * 32 + r) * HS + ks * 16 + 8 * h);
                S0 = __builtin_amdgcn_mfma_f32_32x32x16_bf16(af, b0, S0, 0, 0, 0);
                S1 = __builtin_amdgcn_mfma_f32_32x32x16_bf16(af, b1, S1, 0, 0, 0);
            }
#pragma unroll
            for (int g = 0; g < 4; ++g) {
                u32x2 w0, w1; w0.x = pk2(S0[4 * g], S0[4 * g + 1]); w0.y = pk2(S0[4 * g + 2], S0[4 * g + 3]); w1.x = pk2(S1[4 * g], S1[4 * g + 1]); w1.y = pk2(S1[4 * g + 2], S1[4 * g + 3]);
                *(LAS u32x2*)(SL + (vt0 * 32 + r) * HP + kt * 32 + 8 * g + 4 * h) = w0;
                *(LAS u32x2*)(SL + ((vt0 + 1) * 32 + r) * HP + kt * 32 + 8 * g + 4 * h) = w1;
            }
            const int t = ott * 32 + r;
            const float ms = (SSQ[t] + SSQ[64 + t] + SSQ[128 + t] + SSQ[192 + t]) * (1.f / 128.f);
            const float rstd = 1.f / sqrtf(ms + RMS_EPS);
            const size_t ob = (tok0 + t) * 1024 + hh * 128 + ovt * 32;
#pragma unroll
            for (int g = 0; g < 4; ++g) {
                const u32x2 gg = *(const u32x2*)(GR + ob + 8 * g + 4 * h);
                const float y0 = o[4 * g] * rstd * ng[4 * g] * bflo(gg.x), y1 = o[4 * g + 1] * rstd * ng[4 * g + 1] * bfhi(gg.x);
                const float y2 = o[4 * g + 2] * rstd * ng[4 * g + 2] * bflo(gg.y), y3 = o[4 * g + 3] * rstd * ng[4 * g + 3] * bfhi(gg.y);
                u32x2 wv; wv.x = pk2(y0, y1); wv.y = pk2(y2, y3);
                *(u32x2*)(REC + ob + 8 * g + 4 * h) = wv;
            }
        }
        __syncthreads();
    }
}

DI void ln_resid_phase(Frame& F, const float* g, const float* b) {
    const int gw = F.vcu * NWAVES + F.wave, NGW = F.G * NWAVES, lane = F.lane;
    float* H32 = (float*)(F.ws + WS_H32); bf16* HB = (bf16*)(F.ws + WS_HB); const float* Y32 = (const float*)(F.ws + WS_Y32);
    for (int m = gw; m < NTOK; m += NGW) {
        f32x4 v[4];
#pragma unroll
        for (int j = 0; j < 4; ++j) { const size_t o = (size_t)m * DM + 4 * lane + 256 * j; v[j] = *(const f32x4*)(H32 + o) * ALPHA + *(const f32x4*)(Y32 + o); }
        ln_row(v, g, b, H32 + (size_t)m * DM, HB + (size_t)m * DM, lane);
    }
}

DI void moe_topk_phase(Frame& F, const float* rbias, unsigned* counts) {
    const float* RLOG = (const float*)(F.ws + WS_RLOG); int* TIDX = (int*)(F.ws + WS_TIDX); float* TGATE = (float*)(F.ws + WS_TGATE);
    LAS int* hist = (LAS int*)(F.lds + LDS_KEEP);
    const int lane = F.lane, tid = F.tid, half = lane >> 5;
    const int tpw = (NTOK + F.G - 1) / F.G, t0 = blockIdx.x * tpw, t1 = (t0 + tpw < NTOK) ? t0 + tpw : NTOK;
    if (tid < 256) hist[tid] = 0;
    __syncthreads();
    float bias[4];
#pragma unroll
    for (int j = 0; j < 4; ++j) bias[j] = rbias[lane + 64 * j];
    for (int t = t0 + F.wave; t < t1; t += NWAVES) {
        float sc[4], sel[4];
#pragma unroll
        for (int j = 0; j < 4; ++j) { sc[j] = 1.f / (1.f + __expf(-RLOG[(size_t)t * 256 + lane + 64 * j])); sel[j] = sc[j] + bias[j]; }
        float gs[8];
#pragma unroll
        for (int j = 0; j < 4; ++j) {
            float m1 = sel[j];
#pragma unroll
            for (int o = 1; o < 32; o <<= 1) m1 = fmaxf(m1, __shfl_xor(m1, o));
            const unsigned long long eq = __ballot(sel[j] == m1);
            const unsigned eqh = (unsigned)(eq >> (32 * half));
            const int first = __ffs(eqh) - 1;
            float m2 = ((lane & 31) == first) ? -INFINITY : sel[j];
#pragma unroll
            for (int o = 1; o < 32; o <<= 1) m2 = fmaxf(m2, __shfl_xor(m2, o));
            const float g2 = m1 + m2;
            gs[2 * j] = __shfl(g2, 0); gs[2 * j + 1] = __shfl(g2, 32);
        }
        unsigned gsel = 0;
#pragma unroll
        for (int a = 0; a < 8; ++a) { int rank = 0;
#pragma unroll
            for (int q = 0; q < 8; ++q) rank += (gs[q] > gs[a] || (gs[q] == gs[a] && q < a)) ? 1 : 0;
            if (rank < 4) gsel |= 1u << a; }
        float cand[4];
#pragma unroll
        for (int j = 0; j < 4; ++j) cand[j] = ((gsel >> (2 * j + half)) & 1u) ? sel[j] : -INFINITY;
        int myidx = 0; float mysc = 0.f, ssum = 0.f;
#pragma unroll
        for (int k = 0; k < TOPK; ++k) {
            float bv = cand[0]; int bi = lane;
#pragma unroll
            for (int j = 1; j < 4; ++j) if (cand[j] > bv) { bv = cand[j]; bi = lane + 64 * j; }
#pragma unroll
            for (int o = 1; o < 64; o <<= 1) { const float ov = __shfl_xor(bv, o); const int oi = __shfl_xor(bi, o); if (ov > bv || (ov == bv && oi < bi)) { bv = ov; bi = oi; } }
            const int oj = bi >> 6, ol = bi & 63;
            float s_w = 0.f;
#pragma unroll
            for (int j = 0; j < 4; ++j) if (j == oj) { s_w = sc[j]; if (lane == ol) cand[j] = -INFINITY; }
            s_w = __shfl(s_w, ol);
            ssum += s_w;
            if (lane == k) { myidx = bi; mysc = s_w; }
        }
        if (lane < TOPK) {
            const int rank = __hip_atomic_fetch_add(&hist[myidx], 1, __ATOMIC_RELAXED, __HIP_MEMORY_SCOPE_WORKGROUP);
            TIDX[(size_t)t * TOPK + lane] = myidx | (rank << 8);
            TGATE[(size_t)t * TOPK + lane] = mysc / ssum * 2.5f;
        }
    }
    __syncthreads();
    if (tid < 256) ((int*)(F.ws + WS_MISC))[4096 + blockIdx.x * 256 + tid] = (int)atomicAdd(&counts[tid], (unsigned)hist[tid]);
}
DI void moe_scatter_phase(Frame& F, const unsigned* counts) {
    const int* TIDX = (const int*)(F.ws + WS_TIDX); int* TPOS = (int*)(F.ws + WS_TPOS); int* ROWTOK = (int*)(F.ws + WS_ROWTOK); int* MISC = (int*)(F.ws + WS_MISC);
    LAS int* hist = (LAS int*)(F.lds + LDS_KEEP); LAS int* wgbase = hist + 256; LAS int* padstart = hist + 512;
    const int tid = F.tid;
    const int tpw = (NTOK + F.G - 1) / F.G, t0 = blockIdx.x * tpw, t1 = (t0 + tpw < NTOK) ? t0 + tpw : NTOK;
    if (tid < 256) { hist[tid] = (int)((__hip_atomic_load(counts + tid, __ATOMIC_RELAXED, __HIP_MEMORY_SCOPE_AGENT) + 255u) & ~255u); wgbase[tid] = MISC[4096 + blockIdx.x * 256 + tid]; }
    __syncthreads();
    if (tid < 256) { int s = 0; for (int e = 0; e < tid; ++e) s += hist[e]; padstart[tid] = s;
        if (blockIdx.x == 0) { for (int tl = s >> 8; tl < (s + hist[tid]) >> 8; ++tl) MISC[tl] = tid; if (tid == 255) MISC[2047] = (s + hist[tid]) >> 8; } }
    __syncthreads();
    for (int i = t0 * TOPK + tid; i < t1 * TOPK; i += NTHR) {
        const int v = TIDX[i], e = v & 255, rank = v >> 8;
        const int pos = padstart[e] + wgbase[e] + rank;
        TPOS[i] = pos; ROWTOK[pos] = i >> 3;
    }
}
DI void moe_combine_phase(Frame& F, const float* g, const float* b, float* outp) {
    const int gw = F.vcu * NWAVES + F.wave, NGW = F.G * NWAVES, lane = F.lane;
    float* H32 = (float*)(F.ws + WS_H32); bf16* HB = (bf16*)(F.ws + WS_HB); const float* Y32 = (const float*)(F.ws + WS_Y32);
    const bf16* YS = (const bf16*)(F.ws + WS_YS); const int* TPOS = (const int*)(F.ws + WS_TPOS); const float* TGATE = (const float*)(F.ws + WS_TGATE);
    for (int m = gw; m < NTOK; m += NGW) {
        f32x4 v[4];
#pragma unroll
        for (int j = 0; j < 4; ++j) { const size_t o = (size_t)m * DM + 4 * lane + 256 * j; v[j] = *(const f32x4*)(H32 + o) * ALPHA + *(const f32x4*)(Y32 + o); }
#pragma unroll
        for (int k = 0; k < TOPK; ++k) {
            const int pos = TPOS[(size_t)m * TOPK + k]; const float gk = TGATE[(size_t)m * TOPK + k];
#pragma unroll
            for (int j = 0; j < 4; ++j) { const u32x2 y = *(const u32x2*)(YS + (size_t)pos * DM + 4 * lane + 256 * j);
                v[j][0] += gk * bflo(y.x); v[j][1] += gk * bfhi(y.x); v[j][2] += gk * bflo(y.y); v[j][3] += gk * bfhi(y.y); }
        }
        ln_row(v, g, b, outp ? outp + (size_t)m * DM : H32 + (size_t)m * DM, outp ? (bf16*)nullptr : HB + (size_t)m * DM, lane);
    }
}

constexpr int PH_PER_LAYER = 11, N_PHASES = 1 + 2 * PH_PER_LAYER;
__global__ void __launch_bounds__(NTHR, 2) fwd_kernel(Args args) {
    extern __shared__ __attribute__((aligned(16))) unsigned char lds[];
    Frame F;
    F.lds = (LAS unsigned char*)lds;
    F.tid = threadIdx.x; F.lane = F.tid & 63; F.wave = __builtin_amdgcn_readfirstlane(F.tid >> 6);
    F.G = gridDim.x; { const int bx = blockIdx.x; F.vcu = (F.G % 8 == 0) ? (bx % 8) * (F.G / 8) + bx / 8 : bx; }
    F.ws = args.ws;
    unsigned* ctl = (unsigned*)(F.ws + WS_CTL);
    volatile LAS unsigned* MISCW = (volatile LAS unsigned*)(F.lds + MISC_OFF);
    if (F.tid < 32) MISCW[F.tid] = 0u;
    __syncthreads();
    const int lo = args.ph_lo, hi = args.ph_hi;
    XcdBarrier bar; bar.bar = ctl + CW_BAR; bar.x = 0; bar.st = MISCW + 8;
    if (hi - lo > 1) bar = xcd_barrier_post(ctl + CW_BAR, MISCW + 8);
#define IN(k) (lo <= (k) && (k) < hi)
#define SEAM(k) do { if (IN(k) && IN((k) + 1)) xcd_barrier(bar); } while (0)

    if (IN(0)) prologue(F, args);
    SEAM(0);

    for (int l = 0; l < 2; ++l) {
        const int pb = 1 + PH_PER_LAYER * l;
        if (IN(pb + 0)) { F.ws = opaque_ptr(args.ws); F.tid = opaque_v(threadIdx.x); F.lane = F.tid & 63; F.wave = __builtin_amdgcn_readfirstlane(F.tid >> 6);
            pg8::DenseSched S{(const bf16*)(F.ws + WS_HB), (const bf16*)(F.ws + WS_WIN) + (size_t)l * (INW * 1024), 1024, NTOK / 256, INW / 256, F.G, (int)blockIdx.x};
            pg8::EpiInProj E{F.ws, args.in[I_BIN] + (size_t)l * INW, (const float*)(F.ws + WS_LB) + l * 1024};
            pg8::gemm_phase(F.lds, S, E);
        }
        SEAM(pb + 0);
        if (IN(pb + 1)) { F.ws = opaque_ptr(args.ws); F.tid = opaque_v(threadIdx.x); F.lane = F.tid & 63; F.wave = __builtin_amdgcn_readfirstlane(F.tid >> 6);
            for (int u = F.vcu; u < NB * NCHUNK * 4; u += F.G) { const int hk = u & 3, c = (u >> 2) % NCHUNK, b = u / (4 * NCHUNK); attn_unit(F, b, c, hk, args.in[I_SINK] + l * 16); }
            __syncthreads();
            for (int u = blockIdx.x; u < NB * 8; u += F.G) hgrn_unit(F, u >> 3, u & 7, args.in[I_RNG] + l * 128);
        }
        SEAM(pb + 1);
        if (IN(pb + 2)) { F.ws = opaque_ptr(args.ws); F.tid = opaque_v(threadIdx.x); F.lane = F.tid & 63; F.wave = __builtin_amdgcn_readfirstlane(F.tid >> 6);
            { pg8::DenseSched S{(const bf16*)(F.ws + WS_ATT), (const bf16*)(F.ws + WS_WPA) + (size_t)l * (1024 * 1024), 1024, NTOK / 256, 4, F.G, (int)blockIdx.x};
              pg8::EpiGate<false> E{(bf16*)(F.ws + WS_MRG), (const bf16*)(F.ws + WS_GA)}; pg8::gemm_phase(F.lds, S, E); }
            { pg8::DenseSched S{(const bf16*)(F.ws + WS_REC), (const bf16*)(F.ws + WS_WPR) + (size_t)l * (1024 * 1024), 1024, NTOK / 256, 4, F.G, (int)blockIdx.x};
              pg8::EpiGate<true> E{(bf16*)(F.ws + WS_MRG), (const bf16*)(F.ws + WS_GT)}; pg8::gemm_phase(F.lds, S, E); }
        }
        SEAM(pb + 2);
        if (IN(pb + 3)) { F.ws = opaque_ptr(args.ws); F.tid = opaque_v(threadIdx.x); F.lane = F.tid & 63; F.wave = __builtin_amdgcn_readfirstlane(F.tid >> 6);
            pg8::DenseSched S{(const bf16*)(F.ws + WS_MRG), (const bf16*)(F.ws + WS_WOUT) + (size_t)l * (1024 * 1024), 1024, NTOK / 256, 4, F.G, (int)blockIdx.x};
            pg8::EpiF32 E{(float*)(F.ws + WS_Y32), 1024}; pg8::gemm_phase(F.lds, S, E);
        }
        SEAM(pb + 3);
        if (IN(pb + 4)) { F.ws = opaque_ptr(args.ws); F.tid = opaque_v(threadIdx.x); F.lane = F.tid & 63; F.wave = __builtin_amdgcn_readfirstlane(F.tid >> 6); ln_resid_phase(F, args.in[I_LN1G] + l * 1024, args.in[I_LN1B] + l * 1024); }
        SEAM(pb + 4);
        if (IN(pb + 5)) { F.ws = opaque_ptr(args.ws); F.tid = opaque_v(threadIdx.x); F.lane = F.tid & 63; F.wave = __builtin_amdgcn_readfirstlane(F.tid >> 6);
            pg8::DenseSched S{(const bf16*)(F.ws + WS_HB), (const bf16*)(F.ws + WS_WRS) + (size_t)l * (768 * 1024), 1024, NTOK / 256, 3, F.G, (int)blockIdx.x};
            pg8::EpiRouterShared E{(float*)(F.ws + WS_RLOG), (bf16*)(F.ws + WS_SACT)}; pg8::gemm_phase(F.lds, S, E);
        }
        SEAM(pb + 5);
        if (IN(pb + 6)) { F.ws = opaque_ptr(args.ws); F.tid = opaque_v(threadIdx.x); F.lane = F.tid & 63; F.wave = __builtin_amdgcn_readfirstlane(F.tid >> 6); moe_topk_phase(F, args.in[I_RB] + l * 256, (unsigned*)(F.ws + WS_CTL) + CW_CNT + l * 256); }
        SEAM(pb + 6);
        if (IN(pb + 7)) { F.ws = opaque_ptr(args.ws); F.tid = opaque_v(threadIdx.x); F.lane = F.tid & 63; F.wave = __builtin_amdgcn_readfirstlane(F.tid >> 6); moe_scatter_phase(F, (unsigned*)(F.ws + WS_CTL) + CW_CNT + l * 256); }
        SEAM(pb + 7);
        if (IN(pb + 8)) { F.ws = opaque_ptr(args.ws); F.tid = opaque_v(threadIdx.x); F.lane = F.tid & 63; F.wave = __builtin_amdgcn_readfirstlane(F.tid >> 6);
            const int* MISC = (const int*)(F.ws + WS_MISC); const int ntiles = __builtin_amdgcn_readfirstlane(MISC[2047]);
            { pg8::GroupSched<true> S{(const bf16*)(F.ws + WS_HB), (const bf16*)(F.ws + WS_WEGU) + (size_t)l * 256 * (512 * 1024), (const int*)(F.ws + WS_ROWTOK), MISC, 1024, ntiles, 2, F.G, (int)blockIdx.x, (size_t)512 * 1024};
              pg8::EpiSwiglu E{(bf16*)(F.ws + WS_ACT), 256, 0}; pg8::gemm_phase(F.lds, S, E); }
            { pg8::DenseSched S{(const bf16*)(F.ws + WS_SACT), (const bf16*)(F.ws + WS_WSD) + (size_t)l * (1024 * 256), 256, NTOK / 256, 4, F.G, (int)blockIdx.x};
              pg8::EpiF32 E{(float*)(F.ws + WS_Y32), 1024}; pg8::gemm_phase(F.lds, S, E); }
        }
        SEAM(pb + 8);
        if (IN(pb + 9)) { F.ws = opaque_ptr(args.ws); F.tid = opaque_v(threadIdx.x); F.lane = F.tid & 63; F.wave = __builtin_amdgcn_readfirstlane(F.tid >> 6);
            const int* MISC = (const int*)(F.ws + WS_MISC); const int ntiles = __builtin_amdgcn_readfirstlane(MISC[2047]);
            pg8::GroupSched<false> S{(const bf16*)(F.ws + WS_ACT), (const bf16*)(F.ws + WS_WED) + (size_t)l * 256 * (1024 * 256), nullptr, MISC, 256, ntiles, 4, F.G, (int)blockIdx.x, (size_t)1024 * 256};
            pg8::EpiBf16 E{(bf16*)(F.ws + WS_YS), 1024}; pg8::gemm_phase(F.lds, S, E);
        }
        SEAM(pb + 9);
        if (IN(pb + 10)) { F.ws = opaque_ptr(args.ws); F.tid = opaque_v(threadIdx.x); F.lane = F.tid & 63; F.wave = __builtin_amdgcn_readfirstlane(F.tid >> 6); moe_combine_phase(F, args.in[I_LN2G] + l * 1024, args.in[I_LN2B] + l * 1024, l == 1 ? args.out : (float*)nullptr); }
        if (l == 0) SEAM(pb + 10);
    }
#undef IN
#undef SEAM
}

#ifndef MK_PER_PHASE
#define MK_PER_PHASE 0
#endif
extern "C" void kernel_launch(void* const* d_in, const int* in_sizes, int n_in, void* d_out, int out_size, void* d_ws, size_t ws_size, hipStream_t stream) {
    static int grid = 0;
    if (grid == 0) {
        if (n_in != 21 || out_size != NTOK * DM || ws_size < WS_END) { fprintf(stderr, "kernel_launch: unexpected shapes (n_in %d out %d ws %zu)\n", n_in, out_size, ws_size); grid = -1; return; }
        int dev = 0, cus = 0, per_cu = 0;
        if (hipGetDevice(&dev) != hipSuccess || hipDeviceGetAttribute(&cus, hipDeviceAttributeMultiprocessorCount, dev) != hipSuccess) { grid = -1; return; }
        if (hipFuncSetAttribute((const void*)fwd_kernel, hipFuncAttributeMaxDynamicSharedMemorySize, LDS_BYTES) != hipSuccess) { fprintf(stderr, "kernel_launch: hipFuncSetAttribute failed\n"); grid = -1; return; }
        if (hipOccupancyMaxActiveBlocksPerMultiprocessor(&per_cu, (const void*)fwd_kernel, NTHR, LDS_BYTES) != hipSuccess || per_cu < 1) { fprintf(stderr, "kernel_launch: occupancy query says %d\n", per_cu); }
        (void)hipGetLastError();
        grid = cus;
    }
    if (grid < 0) return;
    (void)hipMemsetAsync((char*)d_ws + WS_CTL, 0, CTL_ZERO_BYTES, stream);
    Args a{};
    for (int i = 0; i < 21; ++i) a.in[i] = (const float*)d_in[i];
    a.out = (float*)d_out; a.ws = (unsigned char*)d_ws;
#if MK_PER_PHASE
    for (int p = 0; p < N_PHASES; ++p) { a.ph_lo = p; a.ph_hi = p + 1; hipLaunchKernelGGL(fwd_kernel, dim3(grid), dim3(NTHR), LDS_BYTES, stream, a); }
#else
    a.ph_lo = 0; a.ph_hi = N_PHASES; hipLaunchKernelGGL(fwd_kernel, dim3(grid), dim3(NTHR), LDS_BYTES, stream, a);
#endif
}
```

```cpp
#include <hip/hip_runtime.h>
#include <cstdio>
#include <cstdint>

#define GAS __attribute__((address_space(1)))
#define LAS __attribute__((address_space(3)))
typedef unsigned short bf16;
typedef short bf16x8 __attribute__((ext_vector_type(8)));
typedef short s16x4 __attribute__((ext_vector_type(4)));
typedef float f32x4 __attribute__((ext_vector_type(4)));
typedef float f32x2 __attribute__((ext_vector_type(2)));
typedef float f32x16 __attribute__((ext_vector_type(16)));
typedef unsigned u32x4 __attribute__((ext_vector_type(4)));
typedef unsigned u32x2 __attribute__((ext_vector_type(2)));
typedef __bf16 bf16x2_t __attribute__((ext_vector_type(2)));
#define DI __device__ __forceinline__

DI unsigned pk2(float lo, float hi) { f32x2 v = {lo, hi}; return __builtin_bit_cast(unsigned, __builtin_convertvector(v, bf16x2_t)); }
DI float bflo(unsigned u) { return __uint_as_float(u << 16); }
DI float bfhi(unsigned u) { return __uint_as_float(u & 0xffff0000u); }
DI float bf2f(bf16 b) { return __uint_as_float((unsigned)b << 16); }
DI float fsigmoid(float x) { return __builtin_amdgcn_rcpf(1.f + __expf(-x)); }
DI float fsilu(float x) { return x * fsigmoid(x); }
DI unsigned char* opaque_ptr(unsigned char* p) { asm volatile("" : "+s"(p)); return p; }
DI int opaque_v(int v) { asm volatile("" : "+v"(v)); return v; }
DI int opaque_int(int v) { asm volatile("" : "+s"(v)); return v; }
DI float wave_sum(float v) {
#pragma unroll
    for (int o = 1; o < 64; o <<= 1) v += __shfl_xor(v, o);
    return v;
}

constexpr int NB = 4, SEQ = 8192, NTOK = NB * SEQ, DM = 1024, INW = 7680, NCHUNK = SEQ / 64;
constexpr int NE = 256, TOPK = 8, EFF = 256, RPAD_MAX = 1280 * 256;
constexpr float ALPHA = 1.4142135623730951f;
constexpr float LN_EPS = 1e-5f, RMS_EPS = 1e-5f;
constexpr int NWAVES = 8, NTHR = 512;

constexpr size_t MiB = 1u << 20;
constexpr size_t WS_CTL = 0, CTL_ZERO_BYTES = 1 * MiB;
constexpr size_t WS_WIN = 2 * MiB;
constexpr size_t WS_WPA = 34 * MiB;
constexpr size_t WS_WPR = 38 * MiB;
constexpr size_t WS_WOUT = 42 * MiB;
constexpr size_t WS_WRS = 46 * MiB;
constexpr size_t WS_WSD = 50 * MiB;
constexpr size_t WS_LB = 52 * MiB;
constexpr size_t WS_MISC = 53 * MiB;
constexpr size_t WS_WEGU = 64 * MiB;
constexpr size_t WS_WED = 576 * MiB;
constexpr size_t WS_H32 = 832 * MiB;
constexpr size_t WS_HB = 960 * MiB;
constexpr size_t WS_QA = 1024 * MiB, WS_KA = 1088 * MiB, WS_VA = 1104 * MiB, WS_QR = 1120 * MiB, WS_LF = 1184 * MiB, WS_IR = 1312 * MiB, WS_GR = 1376 * MiB, WS_GA = 1440 * MiB, WS_GT = 1504 * MiB;
constexpr size_t WS_ATT = 1568 * MiB, WS_REC = 1632 * MiB, WS_MRG = 1696 * MiB, WS_Y32 = 1760 * MiB;
constexpr size_t WS_RLOG = 1888 * MiB, WS_SACT = 1920 * MiB, WS_TIDX = 1936 * MiB, WS_TGATE = 1937 * MiB, WS_TPOS = 1938 * MiB, WS_ROWTOK = 1939 * MiB;
constexpr size_t WS_ACT = 1952 * MiB;
constexpr size_t WS_YS = 2112 * MiB;
constexpr size_t WS_SST = 2752 * MiB;
constexpr size_t WS_SDEC = 2816 * MiB;
constexpr size_t WS_END = 2817 * MiB;
constexpr int CW_BAR = 4096;
constexpr int CW_CNT = 16384;

constexpr int RING_BYTES = 131072;
constexpr int LDS_KEEP = 140 * 1024;
constexpr int MISC_OFF = 144 * 1024;
constexpr int LDS_BYTES = 147456;

namespace pg8 {
constexpr int BM = 256, BK = 64, HALF = 128, HTB = HALF * BK * 2, STAGE_BYTES = 8 * HTB, NXCD = 8, WGM = 8;
__host__ __device__ __forceinline__ int lds_byte(int r, int c) { const int st = (r >> 4) * 2 + (c >> 5), rr = r & 15, cc = c & 31, ob = rr * 64 + cc * 2; return st * 1024 + (ob ^ (((ob >> 9) & 1) << 5)); }
__host__ __device__ __forceinline__ void stage_rc(int b, int& R, int& C) { const int st = b / 1024, sb = b % 1024, swz = sb ^ (((sb >> 9) & 1) << 5); R = (st >> 1) * 16 + swz / 64; C = (st & 1) * 32 + (swz % 64) / 2; }
__host__ __device__ __forceinline__ int perm32(int rho) { const int n = rho >> 4, i = rho & 15; return 8 * (i >> 2) + 4 * n + (i & 3); }

struct Unit { int pm, pn, aux; };

DI bool static_unit(int i, int G, int c, int nM, int nN, Unit& u) {
    const int nwg = nM * nN; const long L = (long)i * G + c; if (L >= nwg) return false;
    int wgid = (int)L; { const int q = nwg / NXCD, r = nwg % NXCD, xcd = wgid % NXCD, off = wgid / NXCD; wgid = (xcd < r ? xcd * (q + 1) : r * (q + 1) + (xcd - r) * q) + off; }
    const int nig = WGM * nN, gid = wgid / nig, fm = gid * WGM, gsz = (nM - fm) < WGM ? (nM - fm) : WGM;
    u.pm = fm + ((wgid % nig) % gsz); u.pn = (wgid % nig) / gsz; u.aux = 0; return true;
}
struct DenseSched {
    const bf16* A; const bf16* Bt; int K, nM, nN, G, c;
    DI bool next(int i, Unit& u) const { return static_unit(i, G, c, nM, nN, u); }
    DI const char* a_base(const Unit& u) const { return (const char*)A + (size_t)u.pm * (size_t)(BM * K * 2); }
    DI const char* b_base(const Unit& u) const { return (const char*)Bt + (size_t)u.pn * (size_t)(BM * K * 2); }
    DI void a_offs(const Unit&, const int (&R)[2], const int (&C)[2], unsigned (&o)[2][2]) const {
#pragma unroll
        for (int h = 0; h < 2; ++h)
#pragma unroll
            for (int i = 0; i < 2; ++i) o[h][i] = (unsigned)((h * HALF + R[i]) * K + C[i]) * 2u;
    }
};
template <bool GATHER> struct GroupSched {
    const bf16* A; const bf16* Bt; const int* rowtok; const int* tile_e; int K, nM, nN, G, c; size_t bstride;
    DI bool next(int i, Unit& u) const { if (!static_unit(i, G, c, nM, nN, u)) return false; u.aux = __builtin_amdgcn_readfirstlane(tile_e[u.pm]); return true; }
    DI const char* a_base(const Unit& u) const { return GATHER ? (const char*)A : (const char*)A + (size_t)u.pm * (size_t)(BM * K * 2); }
    DI const char* b_base(const Unit& u) const { return (const char*)(Bt + (size_t)u.aux * bstride) + (size_t)u.pn * (size_t)(BM * K * 2); }
    DI void a_offs(const Unit& u, const int (&R)[2], const int (&C)[2], unsigned (&o)[2][2]) const {
#pragma unroll
        for (int h = 0; h < 2; ++h)
#pragma unroll
            for (int i = 0; i < 2; ++i) {
                if (GATHER) { const int tok = rowtok[u.pm * BM + h * HALF + R[i]]; o[h][i] = (unsigned)(tok * K + C[i]) * 2u; }
                else o[h][i] = (unsigned)((h * HALF + R[i]) * K + C[i]) * 2u;
            }
    }
};

template <class Epi, class Sched>
DI void gemm_phase(LAS unsigned char* lds, const Sched& S, const Epi& E) {
    const int tid = opaque_v(threadIdx.x), wid = __builtin_amdgcn_readfirstlane(tid >> 6), lane = tid & 63, wr = wid >> 2, wc = wid & 3, fr = lane & 15, fq = lane >> 4;
    const int K = S.K, nt = K / BK;
    int RR[2], CC[2]; unsigned voffB[2];
#pragma unroll
    for (int i = 0; i < 2; ++i) { int R, C; stage_rc(tid * 16 + i * 8192, R, C); const int Rb = (R & ~31) + perm32(R & 31); RR[i] = R; CC[i] = C; voffB[i] = (unsigned)(Rb * K + C) * 2u; }
    const size_t kstep = (size_t)(BK * 2);
    const size_t hstep = (size_t)HALF * K * 2;
    const unsigned ldsw = (unsigned)wid * 1024u;
    const int aoff = lds_byte(wr * 64 + fr, fq * 8), boff = lds_byte(wc * 32 + fr, fq * 8);
#define PG8_SA(b, h) (((b) * 2 + (h)) * HTB)
#define PG8_SB(b, h) ((4 + (b) * 2 + (h)) * HTB)
#define PG8_STAGE(bufoff, gbase, voff) do { _Pragma("unroll") for (int _i = 0; _i < 2; ++_i) \
        __builtin_amdgcn_global_load_lds((const unsigned*)((const char*)(gbase) + (voff)[_i]), (LAS unsigned*)(lds + (bufoff) + ldsw + _i * 8192), 16, 0, 0); } while (0)
#define PG8_LDA(dst, b, h) do { _Pragma("unroll") for (int m = 0; m < 4; ++m) _Pragma("unroll") for (int k = 0; k < 2; ++k) dst[m][k] = *(const LAS bf16x8*)(lds + PG8_SA(b, h) + aoff + m * 2048 + k * 1024); } while (0)
#define PG8_LDB(dst, b, h) do { _Pragma("unroll") for (int n = 0; n < 2; ++n) _Pragma("unroll") for (int k = 0; k < 2; ++k) dst[n][k] = *(const LAS bf16x8*)(lds + PG8_SB(b, h) + boff + n * 2048 + k * 1024); } while (0)
#define PG8_MMA(ai, bj, At, Bt) do { __builtin_amdgcn_s_setprio(1); _Pragma("unroll") for (int m = 0; m < 4; ++m) _Pragma("unroll") for (int n = 0; n < 2; ++n) _Pragma("unroll") for (int k = 0; k < 2; ++k) \
        acc[ai][bj][m][n] = __builtin_amdgcn_mfma_f32_16x16x32_bf16(Bt[n][k], At[m][k], acc[ai][bj][m][n], 0, 0, 0); __builtin_amdgcn_s_setprio(0); } while (0)
#define PG8_WAIT_V(n) asm volatile("s_waitcnt vmcnt(" #n ")" ::: "memory")
#define PG8_WAIT_L(n) asm volatile("s_waitcnt lgkmcnt(" #n ")" ::: "memory")
#define PG8_BAR __builtin_amdgcn_s_barrier()
#define PG8_SCHED __builtin_amdgcn_sched_barrier(0)
    Unit cur, nxt; int ui = 0;
    if (!S.next(0, cur)) return;
    f32x4 acc[2][2][4][2];
#pragma unroll
    for (int a = 0; a < 2; ++a)
#pragma unroll
        for (int b = 0; b < 2; ++b)
#pragma unroll
            for (int m = 0; m < 4; ++m)
#pragma unroll
                for (int n = 0; n < 2; ++n) acc[a][b][m][n] = (f32x4){0.f, 0.f, 0.f, 0.f};
    bf16x8 At[4][2], B0[2][2], B1[2][2];
    const char* cA = S.a_base(cur); const char* cB = S.b_base(cur);
    unsigned oAc[2][2], oAn[2][2];
    S.a_offs(cur, RR, CC, oAc);
    PG8_STAGE(PG8_SB(0, 0), cB, voffB); PG8_STAGE(PG8_SB(0, 1), cB + hstep, voffB); PG8_STAGE(PG8_SA(0, 0), cA, oAc[0]); PG8_STAGE(PG8_SA(0, 1), cA, oAc[1]);
    if (wr == 1) PG8_BAR;
    PG8_WAIT_V(2); PG8_BAR;
    PG8_STAGE(PG8_SB(1, 0), cB + kstep, voffB); PG8_STAGE(PG8_SA(1, 0), cA + kstep, oAc[0]); PG8_STAGE(PG8_SB(1, 1), cB + hstep + kstep, voffB);
    PG8_WAIT_V(6); PG8_BAR;
    for (;;) {
        const bool has_next = S.next(ui + 1, nxt);
        const char* nA = has_next ? S.a_base(nxt) : cA; const char* nB = has_next ? S.b_base(nxt) : cB;
        if (has_next) S.a_offs(nxt, RR, CC, oAn);
        else {
#pragma unroll
            for (int h = 0; h < 2; ++h)
#pragma unroll
                for (int i = 0; i < 2; ++i) oAn[h][i] = oAc[h][i]; }
        for (int t = 0; t < nt; t += 2) {
            const bool last = (t == nt - 2);
            const char* a1 = cA + (size_t)(t + 1) * kstep;
            const char* a2 = last ? nA : cA + (size_t)(t + 2) * kstep; const char* b2 = last ? nB : cB + (size_t)(t + 2) * kstep;
            const char* a3 = a2 + kstep; const char* b3 = b2 + kstep;
            unsigned o2[2][2];
#pragma unroll
            for (int h = 0; h < 2; ++h)
#pragma unroll
                for (int i = 0; i < 2; ++i) o2[h][i] = last ? oAn[h][i] : oAc[h][i];
            PG8_LDB(B0, 0, 0); PG8_LDB(B1, 0, 1); PG8_SCHED; PG8_LDA(At, 0, 0); PG8_STAGE(PG8_SA(1, 1), a1, oAc[1]);
            PG8_WAIT_V(8); PG8_WAIT_L(0); PG8_BAR; PG8_MMA(0, 0, At, B0); PG8_MMA(0, 1, At, B1); PG8_BAR; PG8_SCHED;
            PG8_LDA(At, 0, 1); PG8_STAGE(PG8_SB(0, 0), b2, voffB); PG8_STAGE(PG8_SB(0, 1), b2 + hstep, voffB); PG8_STAGE(PG8_SA(0, 0), a2, o2[0]);
            PG8_WAIT_V(8); PG8_WAIT_L(0); PG8_BAR; PG8_MMA(1, 0, At, B0); PG8_MMA(1, 1, At, B1); PG8_BAR; PG8_SCHED;
            PG8_LDB(B0, 1, 0); PG8_LDB(B1, 1, 1); PG8_SCHED; PG8_LDA(At, 1, 0); PG8_STAGE(PG8_SA(0, 1), a2, o2[1]);
            PG8_WAIT_V(8); PG8_WAIT_L(0); PG8_BAR; PG8_MMA(0, 0, At, B0); PG8_MMA(0, 1, At, B1); PG8_BAR; PG8_SCHED;
            PG8_LDA(At, 1, 1); PG8_STAGE(PG8_SB(1, 0), b3, voffB); PG8_STAGE(PG8_SB(1, 1), b3 + hstep, voffB); PG8_STAGE(PG8_SA(1, 0), a3, o2[0]);
            PG8_WAIT_V(8); PG8_WAIT_L(0); PG8_BAR; PG8_MMA(1, 0, At, B0); PG8_MMA(1, 1, At, B1); PG8_BAR; PG8_SCHED;
        }
        if (wr == 0) PG8_BAR;
        E(acc, cur, wr, wc, fr, fq);
        if (!has_next) break;
#pragma unroll
        for (int a = 0; a < 2; ++a)
#pragma unroll
            for (int b = 0; b < 2; ++b)
#pragma unroll
                for (int m = 0; m < 4; ++m)
#pragma unroll
                    for (int n = 0; n < 2; ++n) acc[a][b][m][n] = (f32x4){0.f, 0.f, 0.f, 0.f};
        cur = nxt; cA = nA; cB = nB; ++ui;
#pragma unroll
        for (int h = 0; h < 2; ++h)
#pragma unroll
            for (int i = 0; i < 2; ++i) oAc[h][i] = oAn[h][i];
        if (wr == 1) PG8_BAR;
    }
    PG8_WAIT_V(0);
    PG8_BAR;
#undef PG8_SA
#undef PG8_SB
#undef PG8_STAGE
#undef PG8_LDA
#undef PG8_LDB
#undef PG8_MMA
#undef PG8_WAIT_V
#undef PG8_WAIT_L
#undef PG8_BAR
#undef PG8_SCHED
}

#define EPI_ROWS_BEGIN  _Pragma("unroll") for (int ai = 0; ai < 2; ++ai) _Pragma("unroll") for (int m = 0; m < 4; ++m) { const int row = u.pm * BM + ai * HALF + wr * 64 + m * 16 + fr;
#define EPI_ROWS_END }

DI u32x4 pack8(f32x4 a, f32x4 b) { u32x4 w; w.x = pk2(a[0], a[1]); w.y = pk2(a[2], a[3]); w.z = pk2(b[0], b[1]); w.w = pk2(b[2], b[3]); return w; }

struct EpiInProj {
    unsigned char* ws; const float* bias; const float* lb;
    DI void operator()(const f32x4 (&acc)[2][2][4][2], const Unit& u, int wr, int wc, int fr, int fq) const {
        const int colt = u.pn * BM;
        int seg, cbase;
        if (colt < 1024) { seg = 0; cbase = colt; } else if (colt < 1280) { seg = 1; cbase = colt - 1024; } else if (colt < 1536) { seg = 2; cbase = colt - 1280; }
        else { seg = 3 + (colt - 1536) / 1024; cbase = (colt - 1536) % 1024; }
        size_t doff; int ld = 1024, act = 0;
        switch (seg) { case 0: doff = WS_QA; break; case 1: doff = WS_KA; ld = 256; break; case 2: doff = WS_VA; ld = 256; break; case 3: doff = WS_QR; act = 1; break;
                       case 4: doff = WS_LF; act = 3; break; case 5: doff = WS_IR; break; case 6: doff = WS_GR; act = 1; break; case 7: doff = WS_GA; act = 2; break; default: doff = WS_GT; act = 2; break; }
        bf16* dst = (bf16*)(ws + doff); float* lf = (float*)(ws + doff);
        const int cw = wc * 32 + 8 * fq;
        f32x4 bv[2][2], lbv[2][2];
#pragma unroll
        for (int bj = 0; bj < 2; ++bj)
#pragma unroll
            for (int n = 0; n < 2; ++n) { bv[bj][n] = *(const f32x4*)(bias + colt + bj * HALF + cw + 4 * n);
                lbv[bj][n] = (act == 3) ? *(const f32x4*)(lb + cbase + bj * HALF + cw + 4 * n) : (f32x4){0.f, 0.f, 0.f, 0.f}; }
        EPI_ROWS_BEGIN
#pragma unroll
            for (int bj = 0; bj < 2; ++bj) {
                f32x4 v[2] = {acc[ai][bj][m][0] + bv[bj][0], acc[ai][bj][m][1] + bv[bj][1]};
                const int c = cbase + bj * HALF + cw;
                if (act == 3) {
#pragma unroll
                    for (int n = 0; n < 2; ++n) {
#pragma unroll
                        for (int e = 0; e < 4; ++e) { const float x = v[n][e]; const float ls = fminf(x, 0.f) - __logf(1.f + __expf(-fabsf(x)));
                            const float l0 = lbv[bj][n][e]; v[n][e] = (l0 > 0.f) ? __logf(l0 + (1.f - l0) * __expf(ls)) : ls; }
                        *(f32x4*)(lf + (size_t)row * 1024 + c + 4 * n) = v[n]; }
                } else {
                    if (act == 1) {
#pragma unroll
                        for (int n = 0; n < 2; ++n)
#pragma unroll
                            for (int e = 0; e < 4; ++e) v[n][e] = fsilu(v[n][e]);
                    } else if (act == 2) {
#pragma unroll
                        for (int n = 0; n < 2; ++n)
#pragma unroll
                            for (int e = 0; e < 4; ++e) v[n][e] = fsigmoid(v[n][e]);
                    }
                    *(u32x4*)(dst + (size_t)row * ld + c) = pack8(v[0], v[1]);
                }
            }
        EPI_ROWS_END
    }
};
struct EpiF32 {
    float* O; int ld;
    DI void operator()(const f32x4 (&acc)[2][2][4][2], const Unit& u, int wr, int wc, int fr, int fq) const {
        const int c0 = u.pn * BM + wc * 32 + 8 * fq;
        EPI_ROWS_BEGIN
#pragma unroll
            for (int bj = 0; bj < 2; ++bj)
#pragma unroll
                for (int n = 0; n < 2; ++n) *(f32x4*)(O + (size_t)row * ld + c0 + bj * HALF + 4 * n) = acc[ai][bj][m][n];
        EPI_ROWS_END
    }
};
struct EpiBf16 {
    bf16* O; int ld;
    DI void operator()(const f32x4 (&acc)[2][2][4][2], const Unit& u, int wr, int wc, int fr, int fq) const {
        const int c0 = u.pn * BM + wc * 32 + 8 * fq;
        EPI_ROWS_BEGIN
#pragma unroll
            for (int bj = 0; bj < 2; ++bj) *(u32x4*)(O + (size_t)row * ld + c0 + bj * HALF) = pack8(acc[ai][bj][m][0], acc[ai][bj][m][1]);
        EPI_ROWS_END
    }
};
template <bool ADD> struct EpiGate {
    bf16* O; const bf16* gate;
    DI void operator()(const f32x4 (&acc)[2][2][4][2], const Unit& u, int wr, int wc, int fr, int fq) const {
        const int c0 = u.pn * BM + wc * 32 + 8 * fq;
        EPI_ROWS_BEGIN
#pragma unroll
            for (int bj = 0; bj < 2; ++bj) {
                const size_t off = (size_t)row * 1024 + c0 + bj * HALF;
                const u32x4 g = *(const u32x4*)(gate + off);
                f32x4 a = acc[ai][bj][m][0], b = acc[ai][bj][m][1];
                a[0] *= bflo(g.x); a[1] *= bfhi(g.x); a[2] *= bflo(g.y); a[3] *= bfhi(g.y); b[0] *= bflo(g.z); b[1] *= bfhi(g.z); b[2] *= bflo(g.w); b[3] *= bfhi(g.w);
                if (ADD) { const u32x4 o = *(const u32x4*)(O + off);
                    a[0] += bflo(o.x); a[1] += bfhi(o.x); a[2] += bflo(o.y); a[3] += bfhi(o.y); b[0] += bflo(o.z); b[1] += bfhi(o.z); b[2] += bflo(o.w); b[3] += bfhi(o.w); }
                *(u32x4*)(O + off) = pack8(a, b);
            }
        EPI_ROWS_END
    }
};
struct EpiSwiglu {
    bf16* O; int ld; int pn0;
    DI void operator()(const f32x4 (&acc)[2][2][4][2], const Unit& u, int wr, int wc, int fr, int fq) const {
        const int c0 = (u.pn - pn0) * HALF + wc * 32 + 8 * fq;
        EPI_ROWS_BEGIN
            f32x4 a, b;
#pragma unroll
            for (int e = 0; e < 4; ++e) { a[e] = fsilu(acc[ai][0][m][0][e]) * acc[ai][1][m][0][e]; b[e] = fsilu(acc[ai][0][m][1][e]) * acc[ai][1][m][1][e]; }
            *(u32x4*)(O + (size_t)row * ld + c0) = pack8(a, b);
        EPI_ROWS_END
    }
};
struct EpiRouterShared {
    float* rlog; bf16* sact;
    DI void operator()(const f32x4 (&acc)[2][2][4][2], const Unit& u, int wr, int wc, int fr, int fq) const {
        if (u.pn == 0) { EpiF32 e{rlog, 256}; e(acc, u, wr, wc, fr, fq); }
        else { EpiSwiglu e{sact, 256, 1}; e(acc, u, wr, wc, fr, fq); }
    }
};
}

#define XB_TMO      128
#define XB_XCNT(j)  (256  + 64 * (j))
#define XB_XSUB(j)  (1280 + 64 * (j))
#define XB_XGEN(j)  (2304 + 64 * (j))
#define XB_TOP      3328
#define XB_TOPGEN   3392
#define XCD_BAR_WORDS 3456
#define XB_SPIN_CAP (1u << 18)

__device__ __forceinline__ unsigned xb_ld(unsigned* p)              { return __hip_atomic_load(p, __ATOMIC_RELAXED, __HIP_MEMORY_SCOPE_AGENT); }
__device__ __forceinline__ unsigned xb_add(unsigned* p, unsigned v) { return __hip_atomic_fetch_add(p, v, __ATOMIC_RELAXED, __HIP_MEMORY_SCOPE_AGENT); }
__device__ __forceinline__ unsigned xb_xcc_id() { return (unsigned)__builtin_amdgcn_s_getreg((3 << 11) | 20) & 0xFu; }
#define XB_SPIN(cond, bar) do { unsigned _sp = 0; while (cond) { __builtin_amdgcn_s_sleep(1); \
    if ((++_sp & 255u) == 0u) { if (xb_ld(&(bar)[XB_TMO])) break; if (_sp > XB_SPIN_CAP) { atomicAdd(&(bar)[XB_TMO], 1u); break; } } } } while (0)

struct XcdBarrier { unsigned* bar; unsigned x; volatile LAS unsigned* st; };

__device__ __forceinline__ XcdBarrier xcd_barrier_post(unsigned* bar, volatile LAS unsigned* st) {
    XcdBarrier b; b.bar = bar; b.x = xb_xcc_id(); b.st = st;
    if (threadIdx.x == 0) (void)xb_add(&bar[XB_XCNT(b.x)], 1u);
    return b;
}
__device__ __forceinline__ void xcd_barrier_complete(unsigned* bar, unsigned x, unsigned& nloc, unsigned& nx) {
    const unsigned G = gridDim.x * gridDim.y * gridDim.z;
    unsigned sum, cnt, mine, sp = 0u;
    for (;;) {
        sum = 0u; cnt = 0u; mine = 0u;
#pragma unroll
        for (unsigned j = 0; j < 16; ++j) { const unsigned c = xb_ld(&bar[XB_XCNT(j)]); sum += c; cnt += (c > 0u) ? 1u : 0u; mine = (j == x) ? c : mine; }
        if (sum == G) break;
        __builtin_amdgcn_s_sleep(1);
        if ((++sp & 255u) == 0u) { if (xb_ld(&bar[XB_TMO])) break; if (sp > XB_SPIN_CAP) { atomicAdd(&bar[XB_TMO], 1u); break; } }
    }
    nloc = mine > 0u ? mine : 1u; nx = cnt > 0u ? cnt : 1u;
}
__device__ __forceinline__ void xcd_barrier(const XcdBarrier& b) {
    asm volatile("s_waitcnt vmcnt(0)" ::: "memory");
    __syncthreads();
    if (threadIdx.x == 0) {
        unsigned* bar = b.bar;
        __builtin_amdgcn_s_waitcnt(0);
        unsigned nloc = b.st[0], nx = b.st[1];
        if (nloc == 0u) { xcd_barrier_complete(bar, b.x, nloc, nx); b.st[0] = nloc; b.st[1] = nx; }
        const unsigned old = xb_add(&bar[XB_XSUB(b.x)], 1u);
        const unsigned gen = old / nloc;
        if (old + 1u == (gen + 1u) * nloc) {
            __builtin_amdgcn_fence(__ATOMIC_RELEASE, "agent");
            asm volatile("s_waitcnt vmcnt(0)" ::: "memory");
            const unsigned og = xb_add(&bar[XB_TOP], 1u);
            const unsigned tg = og / nx;
            if (og + 1u == (tg + 1u) * nx) xb_add(&bar[XB_TOPGEN], 1u);
            else XB_SPIN(xb_ld(&bar[XB_TOPGEN]) == tg, bar);
            __builtin_amdgcn_fence(__ATOMIC_ACQUIRE, "agent");
            xb_add(&bar[XB_XGEN(b.x)], 1u);
            asm volatile("s_waitcnt vmcnt(0)" ::: "memory");
        } else {
            XB_SPIN(xb_ld(&bar[XB_XGEN(b.x)]) == gen, bar);
            __builtin_amdgcn_fence(__ATOMIC_ACQUIRE, "agent");
            asm volatile("s_waitcnt vmcnt(0)" ::: "memory");
        }
    }
    __syncthreads();
}

struct Frame {
    LAS unsigned char* lds;
    int tid, lane, wave, vcu, G;
    unsigned char* ws;
};
struct Args { const float* in[21]; float* out; unsigned char* ws; int ph_lo, ph_hi; };
enum { I_X = 0, I_LNIN_G, I_LNIN_B, I_LB, I_WIN, I_BIN, I_SINK, I_RNG, I_WPA, I_WPR, I_WOUT, I_LN1G, I_LN1B, I_RW, I_RB, I_EGU, I_ED, I_SGU, I_SD, I_LN2G, I_LN2B };

DI void tr_item(const float* __restrict__ W, int ldw, int k0, int n0, bf16* dst, int ldd, int lane) {
    const float* src = W + (size_t)k0 * ldw + n0 + lane;
    bf16* d = dst + (size_t)lane * ldd;
#pragma unroll
    for (int kc = 0; kc < 8; ++kc) {
        float v[8];
#pragma unroll
        for (int j = 0; j < 8; ++j) v[j] = src[(size_t)(kc * 8 + j) * ldw];
        u32x4 o; o.x = pk2(v[0], v[1]); o.y = pk2(v[2], v[3]); o.z = pk2(v[4], v[5]); o.w = pk2(v[6], v[7]);
        *(u32x4*)(d + kc * 8) = o;
    }
}
DI int gu_row(int n) { const int j = n & 255, isu = n >> 8; return (j >> 7) * 256 + isu * 128 + (j & 127); }

DI void ln_row(f32x4 (&v)[4], const float* g, const float* b, float* o32, bf16* o16, int lane) {
    float s = 0.f;
#pragma unroll
    for (int j = 0; j < 4; ++j) s += (v[j][0] + v[j][1]) + (v[j][2] + v[j][3]);
    const float mean = wave_sum(s) * (1.f / DM); float s2 = 0.f;
#pragma unroll
    for (int j = 0; j < 4; ++j) { v[j] = v[j] - mean; s2 += (v[j][0] * v[j][0] + v[j][1] * v[j][1]) + (v[j][2] * v[j][2] + v[j][3] * v[j][3]); }
    const float rstd = 1.f / sqrtf(wave_sum(s2) * (1.f / DM) + LN_EPS);
#pragma unroll
    for (int j = 0; j < 4; ++j) {
        const f32x4 gg = *(const f32x4*)(g + 4 * lane + 256 * j), bb = *(const f32x4*)(b + 4 * lane + 256 * j);
        const f32x4 y = v[j] * rstd * gg + bb;
        if (o32) *(f32x4*)(o32 + 4 * lane + 256 * j) = y;
        if (o16) { u32x2 w; w.x = pk2(y[0], y[1]); w.y = pk2(y[2], y[3]); *(u32x2*)(o16 + 4 * lane + 256 * j) = w; }
    }
}

DI void prologue(Frame& F, const Args& A) {
    const int gw = F.vcu * NWAVES + F.wave, NGW = F.G * NWAVES, lane = F.lane;
    bf16* WIN = (bf16*)(F.ws + WS_WIN); bf16* WPA = (bf16*)(F.ws + WS_WPA); bf16* WPR = (bf16*)(F.ws + WS_WPR); bf16* WOUT = (bf16*)(F.ws + WS_WOUT);
    bf16* WRS = (bf16*)(F.ws + WS_WRS); bf16* WSD = (bf16*)(F.ws + WS_WSD); bf16* WEGU = (bf16*)(F.ws + WS_WEGU); bf16* WED = (bf16*)(F.ws + WS_WED);
    constexpr int N_GU = 512 * 128, N_ED = 512 * 64, N_SM = 2944, NITEMS = N_GU + N_ED + 2 * N_SM;
    for (int it0 = gw; it0 < NITEMS; it0 += NGW) {
        int it = it0;
        if (it < N_GU) { const int le = it >> 7, r = it & 127, kb = r >> 3, nb = r & 7, n0 = nb * 64;
            tr_item(A.in[I_EGU] + (size_t)le * (1024 * 512), 512, kb * 64, n0, WEGU + (size_t)le * (512 * 1024) + (size_t)gu_row(n0) * 1024 + kb * 64, 1024, lane); continue; }
        it -= N_GU;
        if (it < N_ED) { const int le = it >> 6, r = it & 63, kb = r >> 4, nb = r & 15, n0 = nb * 64;
            tr_item(A.in[I_ED] + (size_t)le * (256 * 1024), 1024, kb * 64, n0, WED + (size_t)le * (1024 * 256) + (size_t)n0 * 256 + kb * 64, 256, lane); continue; }
        it -= N_ED;
        const int l = it / N_SM; int r = it % N_SM;
        if (r < 1920) { const int kb = r / 120, nb = r % 120; tr_item(A.in[I_WIN] + (size_t)l * (1024 * INW), INW, kb * 64, nb * 64, WIN + (size_t)l * (INW * 1024) + (size_t)(nb * 64) * 1024 + kb * 64, 1024, lane); continue; }
        r -= 1920;
        if (r < 768) { const int w = r >> 8, q = r & 255, kb = q >> 4, nb = q & 15; const float* src = (w == 0 ? A.in[I_WPA] : (w == 1 ? A.in[I_WPR] : A.in[I_WOUT])) + (size_t)l * (1024 * 1024);
            bf16* dst = (w == 0 ? WPA : (w == 1 ? WPR : WOUT)) + (size_t)l * (1024 * 1024);
            tr_item(src, 1024, kb * 64, nb * 64, dst + (size_t)(nb * 64) * 1024 + kb * 64, 1024, lane); continue; }
        r -= 768;
        if (r < 64) { const int kb = r >> 2, nb = r & 3; tr_item(A.in[I_RW] + (size_t)l * (1024 * 256), 256, kb * 64, nb * 64, WRS + (size_t)l * (768 * 1024) + (size_t)(nb * 64) * 1024 + kb * 64, 1024, lane); continue; }
        r -= 64;
        if (r < 128) { const int kb = r >> 3, nb = r & 7, n0 = nb * 64; tr_item(A.in[I_SGU] + (size_t)l * (1024 * 512), 512, kb * 64, n0, WRS + (size_t)l * (768 * 1024) + (size_t)(256 + gu_row(n0)) * 1024 + kb * 64, 1024, lane); continue; }
        r -= 128;
        { const int kb = r >> 4, nb = r & 15; tr_item(A.in[I_SD] + (size_t)l * (256 * 1024), 1024, kb * 64, nb * 64, WSD + (size_t)l * (1024 * 256) + (size_t)(nb * 64) * 256 + kb * 64, 256, lane); }
    }
    float* H32 = (float*)(F.ws + WS_H32); bf16* HB = (bf16*)(F.ws + WS_HB);
    for (int m = gw; m < NTOK; m += NGW) {
        f32x4 v[4];
#pragma unroll
        for (int j = 0; j < 4; ++j) v[j] = *(const f32x4*)(A.in[I_X] + (size_t)m * DM + 4 * lane + 256 * j);
        ln_row(v, A.in[I_LNIN_G], A.in[I_LNIN_B], H32 + (size_t)m * DM, HB + (size_t)m * DM, lane);
    }
    float* LB = (float*)(F.ws + WS_LB);
    for (int i = blockIdx.x * NTHR + F.tid; i < 1024; i += F.G * NTHR) {
        const float a = A.in[I_LB][i], b = A.in[I_LB][1024 + i], mx = fmaxf(a, b), ea = __expf(a - mx), eb = __expf(b - mx);
        LB[i] = 0.f; LB[1024 + i] = eb / (ea + eb);
    }
    int* ROWTOK = (int*)(F.ws + WS_ROWTOK);
    for (int i = blockIdx.x * NTHR + F.tid; i < RPAD_MAX; i += F.G * NTHR) ROWTOK[i] = 0;
}

constexpr int ATT_VP = 196;
DI int crow(int reg, int h) { return (reg & 3) + 8 * (reg >> 2) + 4 * h; }
DI void attn_unit(Frame& F, int b, int c, int hk, const float* sinks) {
    const bf16* QA = (const bf16*)(F.ws + WS_QA); const bf16* KA = (const bf16*)(F.ws + WS_KA); const bf16* VA = (const bf16*)(F.ws + WS_VA); bf16* ATT = (bf16*)(F.ws + WS_ATT);
    LAS bf16* VT = (LAS bf16*)F.lds;
    const int lane = F.lane, w = F.wave, r = lane & 31, h = lane >> 5;
    const int nkc = (c < 2 ? c : 2) + 1, nkeys = nkc * 64, ktok0 = b * SEQ + (c - (nkc - 1)) * 64;
    __syncthreads();
    for (int ch = F.tid; ch < nkeys * 8; ch += NTHR) {
        const int key = ch >> 3, d0 = (ch & 7) * 8;
        const u32x4 v = *(const u32x4*)(VA + (size_t)(ktok0 + key) * 256 + hk * 64 + d0);
        const unsigned vv[4] = {v.x, v.y, v.z, v.w};
#pragma unroll
        for (int j = 0; j < 4; ++j) { VT[(d0 + 2 * j) * ATT_VP + key] = (bf16)(vv[j] & 0xffffu); VT[(d0 + 2 * j + 1) * ATT_VP + key] = (bf16)(vv[j] >> 16); }
    }
    __syncthreads();
    const int head = hk * 4 + (w >> 1), qtok = b * SEQ + c * 64 + (w & 1) * 32 + r;
    bf16x8 qf[4];
#pragma unroll
    for (int ks = 0; ks < 4; ++ks) qf[ks] = *(const bf16x8*)(QA + (size_t)qtok * 1024 + head * 64 + ks * 16 + 8 * h);
    f32x16 s[6];
#pragma unroll
    for (int kt = 0; kt < 6; ++kt) {
#pragma unroll
        for (int i = 0; i < 16; ++i) s[kt][i] = 0.f;
        if (kt < nkc * 2) {
#pragma unroll
            for (int ks = 0; ks < 4; ++ks) {
                const bf16x8 kf = *(const bf16x8*)(KA + (size_t)(ktok0 + kt * 32 + r) * 256 + hk * 64 + ks * 16 + 8 * h);
                s[kt] = __builtin_amdgcn_mfma_f32_32x32x16_bf16(kf, qf[ks], s[kt], 0, 0, 0);
            }
        }
    }
    const float sink = sinks[head];
    float mx = -INFINITY;
#pragma unroll
    for (int kt = 0; kt < 6; ++kt) if (kt < nkc * 2) {
#pragma unroll
        for (int i = 0; i < 16; ++i) mx = fmaxf(mx, s[kt][i]);
    }
    mx = fmaxf(mx, __shfl_xor(mx, 32));
    mx = fmaxf(mx * 0.125f, sink);
    float sum = 0.f;
#pragma unroll
    for (int kt = 0; kt < 6; ++kt) if (kt < nkc * 2) {
#pragma unroll
        for (int i = 0; i < 16; ++i) { const float p = __expf(s[kt][i] * 0.125f - mx); s[kt][i] = p; sum += p; }
    }
    sum += __shfl_xor(sum, 32);
    const float inv = 1.f / (sum + __expf(sink - mx));
    f32x16 o[2];
#pragma unroll
    for (int dt = 0; dt < 2; ++dt)
#pragma unroll
        for (int i = 0; i < 16; ++i) o[dt][i] = 0.f;
#pragma unroll
    for (int kt = 0; kt < 6; ++kt) if (kt < nkc * 2) {
#pragma unroll
        for (int st = 0; st < 2; ++st) {
            u32x4 pw; pw.x = pk2(s[kt][8 * st + 0], s[kt][8 * st + 1]); pw.y = pk2(s[kt][8 * st + 2], s[kt][8 * st + 3]); pw.z = pk2(s[kt][8 * st + 4], s[kt][8 * st + 5]); pw.w = pk2(s[kt][8 * st + 6], s[kt][8 * st + 7]);
            const bf16x8 ps = __builtin_bit_cast(bf16x8, pw);
#pragma unroll
            for (int dt = 0; dt < 2; ++dt) {
                const LAS bf16* vp = VT + (dt * 32 + r) * ATT_VP + kt * 32 + 16 * st + 4 * h;
                const s16x4 lo = *(const LAS s16x4*)vp, hi = *(const LAS s16x4*)(vp + 8);
                const bf16x8 vf = __builtin_shufflevector(lo, hi, 0, 1, 2, 3, 4, 5, 6, 7);
                o[dt] = __builtin_amdgcn_mfma_f32_32x32x16_bf16(vf, ps, o[dt], 0, 0, 0);
            }
        }
    }
    bf16* orow = ATT + (size_t)qtok * 1024 + head * 64;
#pragma unroll
    for (int dt = 0; dt < 2; ++dt)
#pragma unroll
        for (int g = 0; g < 4; ++g) { u32x2 wv; wv.x = pk2(o[dt][4 * g] * inv, o[dt][4 * g + 1] * inv); wv.y = pk2(o[dt][4 * g + 2] * inv, o[dt][4 * g + 3] * inv);
            *(u32x2*)(orow + dt * 32 + 8 * g + 4 * h) = wv; }
}

constexpr int SCN = 4, NSC = NCHUNK / SCN;
constexpr int HP = 136, HS = 72;
constexpr int HL_Q1 = 0, HL_Q2 = HL_Q1 + 64 * HP * 2, HL_K2 = HL_Q2 + 64 * HP * 2, HL_K3T = HL_K2 + 64 * HP * 2, HL_VT = HL_K3T + 128 * HS * 2, HL_A = HL_VT + 128 * HS * 2,
              HL_S = HL_A + 64 * HS * 2, HL_DEC = HL_S + 128 * HP * 2, HL_SSQ = HL_DEC + 512, HL_END = HL_SSQ + 1024;
static_assert(HL_END <= LDS_KEEP, "hgrn LDS");
DI bf16x8 lds_frag(const LAS bf16* p) { return *(const LAS bf16x8*)p; }
template <int MODE> DI void hgrn_unit(Frame& F, int b, int hh, int sc, const float* rng) {
    const bf16* QR = (const bf16*)(F.ws + WS_QR); const float* LF = (const float*)(F.ws + WS_LF); const bf16* IR = (const bf16*)(F.ws + WS_IR); const bf16* GR = (const bf16*)(F.ws + WS_GR);
    bf16* REC = (bf16*)(F.ws + WS_REC);
    float* SST = (float*)(F.ws + WS_SST) + (size_t)((b * 8 + hh) * NSC + sc) * (128 * 128); float* SDEC = (float*)(F.ws + WS_SDEC) + ((b * 8 + hh) * NSC + sc) * 128;
    LAS bf16* Q1 = (LAS bf16*)(F.lds + HL_Q1); LAS bf16* Q2 = (LAS bf16*)(F.lds + HL_Q2); LAS bf16* K2 = (LAS bf16*)(F.lds + HL_K2); LAS bf16* K3T = (LAS bf16*)(F.lds + HL_K3T);
    LAS bf16* VT = (LAS bf16*)(F.lds + HL_VT); LAS bf16* AL = (LAS bf16*)(F.lds + HL_A); LAS bf16* SL = (LAS bf16*)(F.lds + HL_S);
    LAS float* DEC = (LAS float*)(F.lds + HL_DEC); LAS float* SSQ = (LAS float*)(F.lds + HL_SSQ);
    const int lane = F.lane, w = F.wave, r = lane & 31, h = lane >> 5;
    const int tg = lane >> 3, cp = lane & 7, ch0 = 16 * w + 2 * cp;
    const int kt = w >> 1, vt0 = 2 * (w & 1);
    const int ovt = w & 3, ott = w >> 2;
    f32x16 S0, S1;
    __syncthreads();
    if (MODE == 1) {
#pragma unroll
        for (int i = 0; i < 16; ++i) { const size_t o = (size_t)(kt * 32 + crow(i, h)) * 128 + r; S0[i] = SST[o + vt0 * 32]; S1[i] = SST[o + (vt0 + 1) * 32]; }
#pragma unroll
        for (int g = 0; g < 4; ++g) {
            u32x2 w0, w1; w0.x = pk2(S0[4 * g], S0[4 * g + 1]); w0.y = pk2(S0[4 * g + 2], S0[4 * g + 3]); w1.x = pk2(S1[4 * g], S1[4 * g + 1]); w1.y = pk2(S1[4 * g + 2], S1[4 * g + 3]);
            *(LAS u32x2*)(SL + (vt0 * 32 + r) * HP + kt * 32 + 8 * g + 4 * h) = w0;
            *(LAS u32x2*)(SL + ((vt0 + 1) * 32 + r) * HP + kt * 32 + 8 * g + 4 * h) = w1;
        }
    } else {
#pragma unroll
        for (int i = 0; i < 16; ++i) { S0[i] = 0.f; S1[i] = 0.f; }
    }
    float ng[16];
    if (MODE == 1) {
#pragma unroll
        for (int i = 0; i < 16; ++i) ng[i] = rng[ovt * 32 + crow(i, h)];
    }
    f32x2 dsum = {0.f, 0.f};
    f32x2 lf[8]; unsigned qv[8], vv[8];
    {   const size_t tok0 = (size_t)b * SEQ + (size_t)(sc * SCN) * 64;
#pragma unroll
        for (int j = 0; j < 8; ++j) { const size_t o = (tok0 + 8 * tg + j) * 1024 + hh * 128 + ch0;
            lf[j] = *(const f32x2*)(LF + o); vv[j] = *(const unsigned*)(IR + o); if (MODE == 1) qv[j] = *(const unsigned*)(QR + o); } }
    for (int cc = 0; cc < SCN; ++cc) {
        const size_t tok0 = (size_t)b * SEQ + (size_t)(sc * SCN + cc) * 64;
        {
            f32x2 bcum[8]; f32x2 run = {0.f, 0.f};
#pragma unroll
            for (int j = 0; j < 8; ++j) { run = run + lf[j]; bcum[j] = run; }
            f32x2 incl = run;
#pragma unroll
            for (int d = 8; d < 64; d <<= 1) { const float u0 = __shfl_up(incl[0], d), u1 = __shfl_up(incl[1], d); if (lane >= d) { incl[0] += u0; incl[1] += u1; } }
            const f32x2 excl = incl - run;
            f32x2 bend, bmid; bend[0] = __shfl(incl[0], 56 + cp); bend[1] = __shfl(incl[1], 56 + cp); bmid[0] = __shfl(incl[0], 24 + cp); bmid[1] = __shfl(incl[1], 24 + cp);
            dsum = dsum + bend;
            unsigned k3a[4], k3b[4]; float k3p[2];
#pragma unroll
            for (int j = 0; j < 8; ++j) {
                const f32x2 bb = bcum[j] + excl;
                const float kk0 = 1.f - __expf(lf[j][0]), kk1 = 1.f - __expf(lf[j][1]);
                const int t = 8 * tg + j;
                if (MODE == 1) {
                    const float q0 = bflo(qv[j]), q1 = bfhi(qv[j]);
                    *(LAS unsigned*)(Q1 + t * HP + ch0) = pk2(q0 * __expf(bb[0]), q1 * __expf(bb[1]));
                    *(LAS unsigned*)(Q2 + t * HP + ch0) = pk2(q0 * __expf(bb[0] - bmid[0]), q1 * __expf(bb[1] - bmid[1]));
                    *(LAS unsigned*)(K2 + t * HP + ch0) = pk2(kk0 * __expf(bmid[0] - bb[0]), kk1 * __expf(bmid[1] - bb[1]));
                }
                const float e0 = kk0 * __expf(bend[0] - bb[0]), e1 = kk1 * __expf(bend[1] - bb[1]);
                if (j & 1) { k3a[j >> 1] = pk2(k3p[0], e0); k3b[j >> 1] = pk2(k3p[1], e1); } else { k3p[0] = e0; k3p[1] = e1; }
            }
            *(LAS u32x4*)(K3T + ch0 * HS + 8 * tg) = (u32x4){k3a[0], k3a[1], k3a[2], k3a[3]};
            *(LAS u32x4*)(K3T + (ch0 + 1) * HS + 8 * tg) = (u32x4){k3b[0], k3b[1], k3b[2], k3b[3]};
            u32x4 va, vb;
            va.x = (vv[0] & 0xffffu) | (vv[1] << 16); va.y = (vv[2] & 0xffffu) | (vv[3] << 16); va.z = (vv[4] & 0xffffu) | (vv[5] << 16); va.w = (vv[6] & 0xffffu) | (vv[7] << 16);
            vb.x = (vv[0] >> 16) | (vv[1] & 0xffff0000u); vb.y = (vv[2] >> 16) | (vv[3] & 0xffff0000u); vb.z = (vv[4] >> 16) | (vv[5] & 0xffff0000u); vb.w = (vv[6] >> 16) | (vv[7] & 0xffff0000u);
            *(LAS u32x4*)(VT + ch0 * HS + 8 * tg) = va;
            *(LAS u32x4*)(VT + (ch0 + 1) * HS + 8 * tg) = vb;
            if (tg == 0) { DEC[ch0] = __expf(bend[0]); DEC[ch0 + 1] = __expf(bend[1]); }
        }
        if (cc + 1 < SCN) {
            const size_t tokn = tok0 + 64;
#pragma unroll
            for (int j = 0; j < 8; ++j) { const size_t o = (tokn + 8 * tg + j) * 1024 + hh * 128 + ch0;
                lf[j] = *(const f32x2*)(LF + o); vv[j] = *(const unsigned*)(IR + o); if (MODE == 1) qv[j] = *(const unsigned*)(QR + o); }
        }
        __syncthreads();
        f32x16 o;
        if (MODE == 1) {
            if (w < 3) {
                const int stl = (w == 2) ? 1 : 0, ttl = (w == 0) ? 0 : 1;
                f32x16 a;
#pragma unroll
                for (int i = 0; i < 16; ++i) a[i] = 0.f;
#pragma unroll
                for (int ks = 0; ks < 8; ++ks) {
                    const bf16x8 af = lds_frag(K2 + (stl * 32 + r) * HP + ks * 16 + 8 * h), bf = lds_frag(Q2 + (ttl * 32 + r) * HP + ks * 16 + 8 * h);
                    a = __builtin_amdgcn_mfma_f32_32x32x16_bf16(af, bf, a, 0, 0, 0);
                }
                const int t = ttl * 32 + r;
#pragma unroll
                for (int g = 0; g < 4; ++g) {
                    float x[4];
#pragma unroll
                    for (int e = 0; e < 4; ++e) { const int s = stl * 32 + 8 * g + 4 * h + e; x[e] = (s <= t) ? a[4 * g + e] : 0.f; }
                    u32x2 wv; wv.x = pk2(x[0], x[1]); wv.y = pk2(x[2], x[3]);
                    *(LAS u32x2*)(AL + t * HS + stl * 32 + 8 * g + 4 * h) = wv;
                }
            }
            __syncthreads();
#pragma unroll
            for (int i = 0; i < 16; ++i) o[i] = 0.f;
#pragma unroll
            for (int ks = 0; ks < 8; ++ks) {
                const bf16x8 af = lds_frag(SL + (ovt * 32 + r) * HP + ks * 16 + 8 * h), bf = lds_frag(Q1 + (ott * 32 + r) * HP + ks * 16 + 8 * h);
                o = __builtin_amdgcn_mfma_f32_32x32x16_bf16(af, bf, o, 0, 0, 0);
            }
#pragma unroll
            for (int ks = 0; ks < 4; ++ks) if (ks < 2 * (ott + 1)) {
                const bf16x8 af = lds_frag(VT + (ovt * 32 + r) * HS + ks * 16 + 8 * h), bf = lds_frag(AL + (ott * 32 + r) * HS + ks * 16 + 8 * h);
                o = __builtin_amdgcn_mfma_f32_32x32x16_bf16(af, bf, o, 0, 0, 0);
            }
            {   float ss = 0.f;
#pragma unroll
                for (int i = 0; i < 16; ++i) ss += o[i] * o[i];
                ss += __shfl_xor(ss, 32);
                if (h == 0) SSQ[ovt * 64 + ott * 32 + r] = ss;
            }
            __syncthreads();
        }
        {
#pragma unroll
            for (int i = 0; i < 16; ++i) { const float d = DEC[kt * 32 + crow(i, h)]; S0[i] *= d; S1[i] *= d; }
#pragma unroll
            for (int ks = 0; ks < 4; ++ks) {
                const bf16x8 af = lds_frag(K3T + (kt * 32 + r) * HS + ks * 16 + 8 * h);
                const bf16x8 b0 = lds_frag(VT + (vt0 * 32 + r) * HS + ks * 16 + 8 * h), b1 = lds_frag(VT + ((vt0 + 1) * 32 + r) * HS + ks * 16 + 8 * h);
                S0 = __builtin_amdgcn_mfma_f32_32x32x16_bf16(af, b0, S0, 0, 0, 0);
                S1 = __builtin_amdgcn_mfma_f32_32x32x16_bf16(af, b1, S1, 0, 0, 0);
            }
            if (MODE == 1) {
#pragma unroll
                for (int g = 0; g < 4; ++g) {
                    u32x2 w0, w1; w0.x = pk2(S0[4 * g], S0[4 * g + 1]); w0.y = pk2(S0[4 * g + 2], S0[4 * g + 3]); w1.x = pk2(S1[4 * g], S1[4 * g + 1]); w1.y = pk2(S1[4 * g + 2], S1[4 * g + 3]);
                    *(LAS u32x2*)(SL + (vt0 * 32 + r) * HP + kt * 32 + 8 * g + 4 * h) = w0;
                    *(LAS u32x2*)(SL + ((vt0 + 1) * 32 + r) * HP + kt * 32 + 8 * g + 4 * h) = w1;
                }
                const int t = ott * 32 + r;
                const float ms = (SSQ[t] + SSQ[64 + t] + SSQ[128 + t] + SSQ[192 + t]) * (1.f / 128.f);
                const float rstd = 1.f / sqrtf(ms + RMS_EPS);
                const size_t ob = (tok0 + t) * 1024 + hh * 128 + ovt * 32;
#pragma unroll
                for (int g = 0; g < 4; ++g) {
                    const u32x2 gg = *(const u32x2*)(GR + ob + 8 * g + 4 * h);
                    const float y0 = o[4 * g] * rstd * ng[4 * g] * bflo(gg.x), y1 = o[4 * g + 1] * rstd * ng[4 * g + 1] * bfhi(gg.x);
                    const float y2 = o[4 * g + 2] * rstd * ng[4 * g + 2] * bflo(gg.y), y3 = o[4 * g + 3] * rstd * ng[4 * g + 3] * bfhi(gg.y);
                    u32x2 wv; wv.x = pk2(y0, y1); wv.y = pk2(y2, y3);
                    *(u32x2*)(REC + ob + 8 * g + 4 * h) = wv;
                }
            }
        }
        __syncthreads();
    }
    if (MODE == 0) {
#pragma unroll
        for (int i = 0; i < 16; ++i) { const size_t o = (size_t)(kt * 32 + crow(i, h)) * 128 + r; SST[o + vt0 * 32] = S0[i]; SST[o + (vt0 + 1) * 32] = S1[i]; }
        if (tg == 0) { SDEC[ch0] = __expf(dsum[0]); SDEC[ch0 + 1] = __expf(dsum[1]); }
    }
}
DI void hgrn_scan_phase(Frame& F) {
    float* SST = (float*)(F.ws + WS_SST); const float* SDEC = (const float*)(F.ws + WS_SDEC);
    const int gt = F.vcu * NTHR + F.tid, NT = F.G * NTHR;
    for (int q = gt; q < NB * 8 * 4096; q += NT) {
        const int bh = q >> 12, e4 = q & 4095, k = e4 >> 5, v4 = (e4 & 31) * 4;
        float* p = SST + (size_t)bh * NSC * (128 * 128) + (size_t)k * 128 + v4; const float* dp = SDEC + bh * NSC * 128 + k;
        f32x4 R = {0.f, 0.f, 0.f, 0.f};
#pragma unroll 8
        for (int sc = 0; sc < NSC; ++sc) { const f32x4 loc = *(const f32x4*)(p + (size_t)sc * (128 * 128)); const float d = dp[sc * 128]; *(f32x4*)(p + (size_t)sc * (128 * 128)) = R; R = R * d + loc; }
    }
}

DI void ln_resid_phase(Frame& F, const float* g, const float* b) {
    const int gw = F.vcu * NWAVES + F.wave, NGW = F.G * NWAVES, lane = F.lane;
    float* H32 = (float*)(F.ws + WS_H32); bf16* HB = (bf16*)(F.ws + WS_HB); const float* Y32 = (const float*)(F.ws + WS_Y32);
    for (int m = gw; m < NTOK; m += NGW) {
        f32x4 v[4];
#pragma unroll
        for (int j = 0; j < 4; ++j) { const size_t o = (size_t)m * DM + 4 * lane + 256 * j; v[j] = *(const f32x4*)(H32 + o) * ALPHA + *(const f32x4*)(Y32 + o); }
        ln_row(v, g, b, H32 + (size_t)m * DM, HB + (size_t)m * DM, lane);
    }
}

DI void moe_topk_phase(Frame& F, const float* rbias, unsigned* counts) {
    const float* RLOG = (const float*)(F.ws + WS_RLOG); int* TIDX = (int*)(F.ws + WS_TIDX); float* TGATE = (float*)(F.ws + WS_TGATE);
    LAS int* hist = (LAS int*)(F.lds + LDS_KEEP);
    const int lane = F.lane, tid = F.tid, half = lane >> 5;
    const int tpw = (NTOK + F.G - 1) / F.G, t0 = blockIdx.x * tpw, t1 = (t0 + tpw < NTOK) ? t0 + tpw : NTOK;
    if (tid < 256) hist[tid] = 0;
    __syncthreads();
    float bias[4];
#pragma unroll
    for (int j = 0; j < 4; ++j) bias[j] = rbias[lane + 64 * j];
    for (int t = t0 + F.wave; t < t1; t += NWAVES) {
        float sc[4], sel[4];
#pragma unroll
        for (int j = 0; j < 4; ++j) { sc[j] = 1.f / (1.f + __expf(-RLOG[(size_t)t * 256 + lane + 64 * j])); sel[j] = sc[j] + bias[j]; }
        float gs[8];
#pragma unroll
        for (int j = 0; j < 4; ++j) {
            float m1 = sel[j];
#pragma unroll
            for (int o = 1; o < 32; o <<= 1) m1 = fmaxf(m1, __shfl_xor(m1, o));
            const unsigned long long eq = __ballot(sel[j] == m1);
            const unsigned eqh = (unsigned)(eq >> (32 * half));
            const int first = __ffs(eqh) - 1;
            float m2 = ((lane & 31) == first) ? -INFINITY : sel[j];
#pragma unroll
            for (int o = 1; o < 32; o <<= 1) m2 = fmaxf(m2, __shfl_xor(m2, o));
            const float g2 = m1 + m2;
            gs[2 * j] = __shfl(g2, 0); gs[2 * j + 1] = __shfl(g2, 32);
        }
        unsigned gsel = 0;
#pragma unroll
        for (int a = 0; a < 8; ++a) { int rank = 0;
#pragma unroll
            for (int q = 0; q < 8; ++q) rank += (gs[q] > gs[a] || (gs[q] == gs[a] && q < a)) ? 1 : 0;
            if (rank < 4) gsel |= 1u << a; }
        float cand[4];
#pragma unroll
        for (int j = 0; j < 4; ++j) cand[j] = ((gsel >> (2 * j + half)) & 1u) ? sel[j] : -INFINITY;
        int myidx = 0; float mysc = 0.f, ssum = 0.f;
#pragma unroll
        for (int k = 0; k < TOPK; ++k) {
            float bv = cand[0]; int bi = lane;
#pragma unroll
            for (int j = 1; j < 4; ++j) if (cand[j] > bv) { bv = cand[j]; bi = lane + 64 * j; }
#pragma unroll
            for (int o = 1; o < 64; o <<= 1) { const float ov = __shfl_xor(bv, o); const int oi = __shfl_xor(bi, o); if (ov > bv || (ov == bv && oi < bi)) { bv = ov; bi = oi; } }
            const int oj = bi >> 6, ol = bi & 63;
            float s_w = 0.f;
#pragma unroll
            for (int j = 0; j < 4; ++j) if (j == oj) { s_w = sc[j]; if (lane == ol) cand[j] = -INFINITY; }
            s_w = __shfl(s_w, ol);
            ssum += s_w;
            if (lane == k) { myidx = bi; mysc = s_w; }
        }
        if (lane < TOPK) {
            const int rank = __hip_atomic_fetch_add(&hist[myidx], 1, __ATOMIC_RELAXED, __HIP_MEMORY_SCOPE_WORKGROUP);
            TIDX[(size_t)t * TOPK + lane] = myidx | (rank << 8);
            TGATE[(size_t)t * TOPK + lane] = mysc / ssum * 2.5f;
        }
    }
    __syncthreads();
    if (tid < 256) ((int*)(F.ws + WS_MISC))[4096 + blockIdx.x * 256 + tid] = (int)atomicAdd(&counts[tid], (unsigned)hist[tid]);
}
DI void moe_scatter_phase(Frame& F, const unsigned* counts) {
    const int* TIDX = (const int*)(F.ws + WS_TIDX); int* TPOS = (int*)(F.ws + WS_TPOS); int* ROWTOK = (int*)(F.ws + WS_ROWTOK); int* MISC = (int*)(F.ws + WS_MISC);
    LAS int* hist = (LAS int*)(F.lds + LDS_KEEP); LAS int* wgbase = hist + 256; LAS int* padstart = hist + 512;
    const int tid = F.tid;
    const int tpw = (NTOK + F.G - 1) / F.G, t0 = blockIdx.x * tpw, t1 = (t0 + tpw < NTOK) ? t0 + tpw : NTOK;
    if (tid < 256) { hist[tid] = (int)((__hip_atomic_load(counts + tid, __ATOMIC_RELAXED, __HIP_MEMORY_SCOPE_AGENT) + 255u) & ~255u); wgbase[tid] = MISC[4096 + blockIdx.x * 256 + tid]; }
    __syncthreads();
    if (tid < 256) { int s = 0; for (int e = 0; e < tid; ++e) s += hist[e]; padstart[tid] = s;
        if (blockIdx.x == 0) { for (int tl = s >> 8; tl < (s + hist[tid]) >> 8; ++tl) MISC[tl] = tid; if (tid == 255) MISC[2047] = (s + hist[tid]) >> 8; } }
    __syncthreads();
    for (int i = t0 * TOPK + tid; i < t1 * TOPK; i += NTHR) {
        const int v = TIDX[i], e = v & 255, rank = v >> 8;
        const int pos = padstart[e] + wgbase[e] + rank;
        TPOS[i] = pos; ROWTOK[pos] = i >> 3;
    }
}
DI void moe_combine_phase(Frame& F, const float* g, const float* b, float* outp) {
    const int gw = F.vcu * NWAVES + F.wave, NGW = F.G * NWAVES, lane = F.lane;
    float* H32 = (float*)(F.ws + WS_H32); bf16* HB = (bf16*)(F.ws + WS_HB); const float* Y32 = (const float*)(F.ws + WS_Y32);
    const bf16* YS = (const bf16*)(F.ws + WS_YS); const int* TPOS = (const int*)(F.ws + WS_TPOS); const float* TGATE = (const float*)(F.ws + WS_TGATE);
    for (int m = gw; m < NTOK; m += NGW) {
        f32x4 v[4];
#pragma unroll
        for (int j = 0; j < 4; ++j) { const size_t o = (size_t)m * DM + 4 * lane + 256 * j; v[j] = *(const f32x4*)(H32 + o) * ALPHA + *(const f32x4*)(Y32 + o); }
#pragma unroll
        for (int k = 0; k < TOPK; ++k) {
            const int pos = TPOS[(size_t)m * TOPK + k]; const float gk = TGATE[(size_t)m * TOPK + k];
#pragma unroll
            for (int j = 0; j < 4; ++j) { const u32x2 y = *(const u32x2*)(YS + (size_t)pos * DM + 4 * lane + 256 * j);
                v[j][0] += gk * bflo(y.x); v[j][1] += gk * bfhi(y.x); v[j][2] += gk * bflo(y.y); v[j][3] += gk * bfhi(y.y); }
        }
        ln_row(v, g, b, outp ? outp + (size_t)m * DM : H32 + (size_t)m * DM, outp ? (bf16*)nullptr : HB + (size_t)m * DM, lane);
    }
}

constexpr int PH_PER_LAYER = 13, N_PHASES = 1 + 2 * PH_PER_LAYER;
__global__ void __launch_bounds__(NTHR, 2) fwd_kernel(Args args) {
    extern __shared__ __attribute__((aligned(16))) unsigned char lds[];
    Frame F;
    F.lds = (LAS unsigned char*)lds;
    F.tid = threadIdx.x; F.lane = F.tid & 63; F.wave = __builtin_amdgcn_readfirstlane(F.tid >> 6);
    F.G = gridDim.x; { const int bx = blockIdx.x; F.vcu = (F.G % 8 == 0) ? (bx % 8) * (F.G / 8) + bx / 8 : bx; }
    F.ws = args.ws;
    unsigned* ctl = (unsigned*)(F.ws + WS_CTL);
    volatile LAS unsigned* MISCW = (volatile LAS unsigned*)(F.lds + MISC_OFF);
    if (F.tid < 32) MISCW[F.tid] = 0u;
    __syncthreads();
    const int lo = args.ph_lo, hi = args.ph_hi;
    XcdBarrier bar; bar.bar = ctl + CW_BAR; bar.x = 0; bar.st = MISCW + 8;
    if (hi - lo > 1) bar = xcd_barrier_post(ctl + CW_BAR, MISCW + 8);
#define IN(k) (lo <= (k) && (k) < hi)
#define SEAM(k) do { if (IN(k) && IN((k) + 1)) xcd_barrier(bar); } while (0)

    if (IN(0)) prologue(F, args);
    SEAM(0);

#define PHASE_ENTER() do { F.ws = opaque_ptr(args.ws); F.tid = opaque_v(threadIdx.x); F.lane = F.tid & 63; F.wave = __builtin_amdgcn_readfirstlane(F.tid >> 6); } while (0)
    enum { P_INPROJ = 0, P_MIX_A, P_SCAN, P_MIX_C, P_PROJ, P_WOUT, P_LN1, P_ROUTER, P_TOPK, P_SCATTER, P_EXP_GU, P_EXP_DOWN, P_COMBINE };
    static_assert(P_COMBINE + 1 == PH_PER_LAYER, "phase count");
    for (int l = 0; l < 2; ++l) {
        const int pb = 1 + PH_PER_LAYER * l;
        if (IN(pb + P_INPROJ)) { PHASE_ENTER();
            pg8::DenseSched S{(const bf16*)(F.ws + WS_HB), (const bf16*)(F.ws + WS_WIN) + (size_t)l * (INW * 1024), 1024, NTOK / 256, INW / 256, F.G, (int)blockIdx.x};
            pg8::EpiInProj E{F.ws, args.in[I_BIN] + (size_t)l * INW, (const float*)(F.ws + WS_LB) + l * 1024};
            pg8::gemm_phase(F.lds, S, E);
        }
        SEAM(pb + P_INPROJ);
        if (IN(pb + P_MIX_A)) { PHASE_ENTER();
            for (int u = F.vcu; u < NB * NCHUNK * 4; u += F.G) { const int hk = u & 3, c = (u >> 2) % NCHUNK, b = u / (4 * NCHUNK); attn_unit(F, b, c, hk, args.in[I_SINK] + l * 16); }
            for (int u = F.vcu; u < NB * 8 * NSC; u += F.G) { const int sc = u % NSC, bh = u / NSC; hgrn_unit<0>(F, bh >> 3, bh & 7, sc, nullptr); }
        }
        SEAM(pb + P_MIX_A);
        if (IN(pb + P_SCAN)) { PHASE_ENTER(); hgrn_scan_phase(F); }
        SEAM(pb + P_SCAN);
        if (IN(pb + P_MIX_C)) { PHASE_ENTER();
            for (int u = F.vcu; u < NB * 8 * NSC; u += F.G) { const int sc = u % NSC, bh = u / NSC; hgrn_unit<1>(F, bh >> 3, bh & 7, sc, args.in[I_RNG] + l * 128); }
        }
        SEAM(pb + P_MIX_C);
        if (IN(pb + P_PROJ)) { PHASE_ENTER();
            { pg8::DenseSched S{(const bf16*)(F.ws + WS_ATT), (const bf16*)(F.ws + WS_WPA) + (size_t)l * (1024 * 1024), 1024, NTOK / 256, 4, F.G, (int)blockIdx.x};
              pg8::EpiGate<false> E{(bf16*)(F.ws + WS_MRG), (const bf16*)(F.ws + WS_GA)}; pg8::gemm_phase(F.lds, S, E); }
            { pg8::DenseSched S{(const bf16*)(F.ws + WS_REC), (const bf16*)(F.ws + WS_WPR) + (size_t)l * (1024 * 1024), 1024, NTOK / 256, 4, F.G, (int)blockIdx.x};
              pg8::EpiGate<true> E{(bf16*)(F.ws + WS_MRG), (const bf16*)(F.ws + WS_GT)}; pg8::gemm_phase(F.lds, S, E); }
        }
        SEAM(pb + P_PROJ);
        if (IN(pb + P_WOUT)) { PHASE_ENTER();
            pg8::DenseSched S{(const bf16*)(F.ws + WS_MRG), (const bf16*)(F.ws + WS_WOUT) + (size_t)l * (1024 * 1024), 1024, NTOK / 256, 4, F.G, (int)blockIdx.x};
            pg8::EpiF32 E{(float*)(F.ws + WS_Y32), 1024}; pg8::gemm_phase(F.lds, S, E);
        }
        SEAM(pb + P_WOUT);
        if (IN(pb + P_LN1)) { PHASE_ENTER(); ln_resid_phase(F, args.in[I_LN1G] + l * 1024, args.in[I_LN1B] + l * 1024); }
        SEAM(pb + P_LN1);
        if (IN(pb + P_ROUTER)) { PHASE_ENTER();
            pg8::DenseSched S{(const bf16*)(F.ws + WS_HB), (const bf16*)(F.ws + WS_WRS) + (size_t)l * (768 * 1024), 1024, NTOK / 256, 3, F.G, (int)blockIdx.x};
            pg8::EpiRouterShared E{(float*)(F.ws + WS_RLOG), (bf16*)(F.ws + WS_SACT)}; pg8::gemm_phase(F.lds, S, E);
        }
        SEAM(pb + P_ROUTER);
        if (IN(pb + P_TOPK)) { PHASE_ENTER(); moe_topk_phase(F, args.in[I_RB] + l * 256, (unsigned*)(F.ws + WS_CTL) + CW_CNT + l * 256); }
        SEAM(pb + P_TOPK);
        if (IN(pb + P_SCATTER)) { PHASE_ENTER(); moe_scatter_phase(F, (unsigned*)(F.ws + WS_CTL) + CW_CNT + l * 256); }
        SEAM(pb + P_SCATTER);
        if (IN(pb + P_EXP_GU)) { PHASE_ENTER();
            const int* MISC = (const int*)(F.ws + WS_MISC); const int ntiles = __builtin_amdgcn_readfirstlane(MISC[2047]);
            { pg8::GroupSched<true> S{(const bf16*)(F.ws + WS_HB), (const bf16*)(F.ws + WS_WEGU) + (size_t)l * 256 * (512 * 1024), (const int*)(F.ws + WS_ROWTOK), MISC, 1024, ntiles, 2, F.G, (int)blockIdx.x, (size_t)512 * 1024};
              pg8::EpiSwiglu E{(bf16*)(F.ws + WS_ACT), 256, 0}; pg8::gemm_phase(F.lds, S, E); }
            { pg8::DenseSched S{(const bf16*)(F.ws + WS_SACT), (const bf16*)(F.ws + WS_WSD) + (size_t)l * (1024 * 256), 256, NTOK / 256, 4, F.G, (int)blockIdx.x};
              pg8::EpiF32 E{(float*)(F.ws + WS_Y32), 1024}; pg8::gemm_phase(F.lds, S, E); }
        }
        SEAM(pb + P_EXP_GU);
        if (IN(pb + P_EXP_DOWN)) { PHASE_ENTER();
            const int* MISC = (const int*)(F.ws + WS_MISC); const int ntiles = __builtin_amdgcn_readfirstlane(MISC[2047]);
            pg8::GroupSched<false> S{(const bf16*)(F.ws + WS_ACT), (const bf16*)(F.ws + WS_WED) + (size_t)l * 256 * (1024 * 256), nullptr, MISC, 256, ntiles, 4, F.G, (int)blockIdx.x, (size_t)1024 * 256};
            pg8::EpiBf16 E{(bf16*)(F.ws + WS_YS), 1024}; pg8::gemm_phase(F.lds, S, E);
        }
        SEAM(pb + P_EXP_DOWN);
        if (IN(pb + P_COMBINE)) { PHASE_ENTER(); moe_combine_phase(F, args.in[I_LN2G] + l * 1024, args.in[I_LN2B] + l * 1024, l == 1 ? args.out : (float*)nullptr); }
        if (l == 0) SEAM(pb + P_COMBINE);
    }
#undef IN
#undef SEAM
}

#ifndef MK_PER_PHASE
#define MK_PER_PHASE 0
#endif
extern "C" void kernel_launch(void* const* d_in, const int* in_sizes, int n_in, void* d_out, int out_size, void* d_ws, size_t ws_size, hipStream_t stream) {
    static int grid = 0;
    if (grid == 0) {
        if (n_in != 21 || out_size != NTOK * DM || ws_size < WS_END) { fprintf(stderr, "kernel_launch: unexpected shapes (n_in %d out %d ws %zu)\n", n_in, out_size, ws_size); grid = -1; return; }
        int dev = 0, cus = 0, per_cu = 0;
        if (hipGetDevice(&dev) != hipSuccess || hipDeviceGetAttribute(&cus, hipDeviceAttributeMultiprocessorCount, dev) != hipSuccess) { grid = -1; return; }
        if (hipFuncSetAttribute((const void*)fwd_kernel, hipFuncAttributeMaxDynamicSharedMemorySize, LDS_BYTES) != hipSuccess) { fprintf(stderr, "kernel_launch: hipFuncSetAttribute failed\n"); grid = -1; return; }
        if (hipOccupancyMaxActiveBlocksPerMultiprocessor(&per_cu, (const void*)fwd_kernel, NTHR, LDS_BYTES) != hipSuccess || per_cu < 1) { fprintf(stderr, "kernel_launch: occupancy query says %d\n", per_cu); }
        (void)hipGetLastError();
        grid = cus;
    }
    if (grid < 0) return;
    (void)hipMemsetAsync((char*)d_ws + WS_CTL, 0, CTL_ZERO_BYTES, stream);
    Args a{};
    for (int i = 0; i < 21; ++i) a.in[i] = (const float*)d_in[i];
    a.out = (float*)d_out; a.ws = (unsigned char*)d_ws;
#if MK_PER_PHASE
    for (int p = 0; p < N_PHASES; ++p) { a.ph_lo = p; a.ph_hi = p + 1; hipLaunchKernelGGL(fwd_kernel, dim3(grid), dim3(NTHR), LDS_BYTES, stream, a); }
#else
    a.ph_lo = 0; a.ph_hi = N_PHASES; hipLaunchKernelGGL(fwd_kernel, dim3(grid), dim3(NTHR), LDS_BYTES, stream, a);
#endif
}
```

```cpp
#include <hip/hip_runtime.h>
#include <cstdio>
#include <cstdint>

#define GAS __attribute__((address_space(1)))
#define LAS __attribute__((address_space(3)))
typedef unsigned short bf16;
typedef short bf16x8 __attribute__((ext_vector_type(8)));
typedef short s16x4 __attribute__((ext_vector_type(4)));
typedef float f32x4 __attribute__((ext_vector_type(4)));
typedef float f32x2 __attribute__((ext_vector_type(2)));
typedef float f32x16 __attribute__((ext_vector_type(16)));
typedef unsigned u32x4 __attribute__((ext_vector_type(4)));
typedef unsigned u32x2 __attribute__((ext_vector_type(2)));
typedef __bf16 bf16x2_t __attribute__((ext_vector_type(2)));
typedef int v8i __attribute__((ext_vector_type(8)));
typedef int v4i __attribute__((ext_vector_type(4)));
#define DI __device__ __forceinline__

DI unsigned pk2(float lo, float hi) { f32x2 v = {lo, hi}; return __builtin_bit_cast(unsigned, __builtin_convertvector(v, bf16x2_t)); }
DI float clamp448(float x) { return __builtin_amdgcn_fmed3f(x, -448.f, 448.f); }
DI unsigned pk4_fp8(float a, float b, float c, float d) {
    int w = __builtin_amdgcn_cvt_pk_fp8_f32(clamp448(a), clamp448(b), 0, false);
    w = __builtin_amdgcn_cvt_pk_fp8_f32(clamp448(c), clamp448(d), w, true);
    return (unsigned)w;
}
DI float bflo(unsigned u) { return __uint_as_float(u << 16); }
DI float bfhi(unsigned u) { return __uint_as_float(u & 0xffff0000u); }
DI float bf2f(bf16 b) { return __uint_as_float((unsigned)b << 16); }
DI float fsigmoid(float x) { return __builtin_amdgcn_rcpf(1.f + __expf(-x)); }
DI float fsilu(float x) { return x * fsigmoid(x); }
DI unsigned char* opaque_ptr(unsigned char* p) { asm volatile("" : "+s"(p)); return p; }
DI int opaque_v(int v) { asm volatile("" : "+v"(v)); return v; }
DI int opaque_int(int v) { asm volatile("" : "+s"(v)); return v; }
template <int CTRL, int RM> DI unsigned dpp_umax(unsigned v) { const unsigned o = (unsigned)__builtin_amdgcn_update_dpp(0, (int)v, CTRL, RM, 0xf, false); return v > o ? v : o; }
DI void half_umax(unsigned v, unsigned& lo, unsigned& hi) {
    v = dpp_umax<0x111, 0xf>(v); v = dpp_umax<0x112, 0xf>(v); v = dpp_umax<0x114, 0xf>(v); v = dpp_umax<0x118, 0xf>(v);
    v = dpp_umax<0x142, 0xa>(v);
    lo = (unsigned)__builtin_amdgcn_readlane((int)v, 31); hi = (unsigned)__builtin_amdgcn_readlane((int)v, 63);
}
DI unsigned wave_umax(unsigned v) { unsigned lo, hi; half_umax(v, lo, hi); return lo > hi ? lo : hi; }
DI unsigned f2key(float f) { const unsigned u = __float_as_uint(f); return (u & 0x80000000u) ? ~u : (u | 0x80000000u); }
DI float key2f(unsigned k) { return __uint_as_float((k & 0x80000000u) ? (k & 0x7fffffffu) : ~k); }
DI float wave_sum(float v) {
#pragma unroll
    for (int o = 1; o < 64; o <<= 1) v += __shfl_xor(v, o);
    return v;
}

constexpr int NB = 4, SEQ = 8192, NTOK = NB * SEQ, DM = 1024, INW = 7680, NCHUNK = SEQ / 64;
constexpr int NE = 256, TOPK = 8, EFF = 256, RPAD_MAX = 1280 * 256;
constexpr float ALPHA = 1.4142135623730951f;
constexpr float LN_EPS = 1e-5f, RMS_EPS = 1e-5f;
constexpr int NWAVES = 8, NTHR = 512;

constexpr size_t MiB = 1u << 20;
constexpr size_t WS_CTL = 0, CTL_ZERO_BYTES = 1 * MiB;
constexpr size_t WS_WIN = 2 * MiB;
constexpr size_t WS_WPA = 34 * MiB;
constexpr size_t WS_WPR = 38 * MiB;
constexpr size_t WS_WOUT = 42 * MiB;
constexpr size_t WS_WRS = 46 * MiB;
constexpr size_t WS_WSD = 50 * MiB;
constexpr size_t WS_LB = 52 * MiB;
constexpr size_t WS_MISC = 53 * MiB;
constexpr size_t WS_WEGU = 64 * MiB;
constexpr size_t WS_WED = 576 * MiB;
constexpr size_t WS_H32 = 832 * MiB;
constexpr size_t WS_HB = 960 * MiB;
constexpr size_t WS_QA = 1024 * MiB, WS_KA = 1088 * MiB, WS_VA = 1104 * MiB, WS_QR = 1120 * MiB, WS_LF = 1184 * MiB, WS_IR = 1312 * MiB, WS_GR = 1376 * MiB, WS_GA = 1440 * MiB, WS_GT = 1504 * MiB;
constexpr size_t WS_ATT = 1568 * MiB, WS_REC = 1632 * MiB, WS_MRG = 1696 * MiB, WS_Y32 = 1760 * MiB;
constexpr size_t WS_RLOG = 1888 * MiB, WS_SACT = 1920 * MiB, WS_TIDX = 1936 * MiB, WS_TGATE = 1937 * MiB, WS_TPOS = 1938 * MiB, WS_ROWTOK = 1939 * MiB;
constexpr size_t WS_ACT = 1952 * MiB;
constexpr size_t WS_YS = 2112 * MiB;
constexpr size_t WS_SST = 2752 * MiB;
constexpr size_t WS_SDEC = 2816 * MiB;
constexpr size_t WS_H32B = 2818 * MiB;
constexpr size_t WS_SIN = 2946 * MiB;
constexpr size_t WS_H8 = 3010 * MiB;
constexpr size_t WS_END = 3042 * MiB;
constexpr int CW_BAR = 4096;
constexpr int CW_CNT = 16384;

constexpr int RING_BYTES = 131072;
constexpr int LDS_KEEP = 140 * 1024;
constexpr int MISC_OFF = 144 * 1024;
constexpr int LDS_BYTES = 147456;

namespace pg8 {
constexpr int BM = 256, BK = 64, HALF = 128, HTB = HALF * BK * 2, STAGE_BYTES = 8 * HTB, NXCD = 8, WGM = 8;
__host__ __device__ __forceinline__ int lds_byte(int r, int c) { const int st = (r >> 4) * 2 + (c >> 5), rr = r & 15, cc = c & 31, ob = rr * 64 + cc * 2; return st * 1024 + (ob ^ (((ob >> 9) & 1) << 5)); }
__host__ __device__ __forceinline__ void stage_rc(int b, int& R, int& C) { const int st = b / 1024, sb = b % 1024, swz = sb ^ (((sb >> 9) & 1) << 5); R = (st >> 1) * 16 + swz / 64; C = (st & 1) * 32 + (swz % 64) / 2; }
__host__ __device__ __forceinline__ int perm32(int rho) { const int n = rho >> 4, i = rho & 15; return 8 * (i >> 2) + 4 * n + (i & 3); }

struct Unit { int pm, pn, aux; };

DI bool static_unit(int i, int G, int c, int nM, int nN, Unit& u) {
    const int nwg = nM * nN; const long L = (long)i * G + c; if (L >= nwg) return false;
    int wgid = (int)L; { const int q = nwg / NXCD, r = nwg % NXCD, xcd = wgid % NXCD, off = wgid / NXCD; wgid = (xcd < r ? xcd * (q + 1) : r * (q + 1) + (xcd - r) * q) + off; }
    const int nig = WGM * nN, gid = wgid / nig, fm = gid * WGM, gsz = (nM - fm) < WGM ? (nM - fm) : WGM;
    u.pm = fm + ((wgid % nig) % gsz); u.pn = (wgid % nig) / gsz; u.aux = 0; return true;
}
struct DenseSched {
    const bf16* A; const bf16* Bt; int K, nM, nN, G, c;
    DI bool next(int i, Unit& u) const { return static_unit(i, G, c, nM, nN, u); }
    DI const char* a_base(const Unit& u) const { return (const char*)A + (size_t)u.pm * (size_t)(BM * K * 2); }
    DI const char* b_base(const Unit& u) const { return (const char*)Bt + (size_t)u.pn * (size_t)(BM * K * 2); }
    DI void a_offs(const Unit&, const int (&R)[2], const int (&C)[2], unsigned (&o)[2][2]) const {
#pragma unroll
        for (int h = 0; h < 2; ++h)
#pragma unroll
            for (int i = 0; i < 2; ++i) o[h][i] = (unsigned)((h * HALF + R[i]) * K + C[i]) * 2u;
    }
};
template <bool GATHER> struct GroupSched {
    const bf16* A; const bf16* Bt; const int* rowtok; const int* tile_e; int K, nM, nN, G, c; size_t bstride;
    DI bool next(int i, Unit& u) const { if (!static_unit(i, G, c, nM, nN, u)) return false; u.aux = __builtin_amdgcn_readfirstlane(tile_e[u.pm]); return true; }
    DI const char* a_base(const Unit& u) const { return GATHER ? (const char*)A : (const char*)A + (size_t)u.pm * (size_t)(BM * K * 2); }
    DI const char* b_base(const Unit& u) const { return (const char*)(Bt + (size_t)u.aux * bstride) + (size_t)u.pn * (size_t)(BM * K * 2); }
    DI void a_offs(const Unit& u, const int (&R)[2], const int (&C)[2], unsigned (&o)[2][2]) const {
#pragma unroll
        for (int h = 0; h < 2; ++h)
#pragma unroll
            for (int i = 0; i < 2; ++i) {
                if (GATHER) { const int tok = rowtok[u.pm * BM + h * HALF + R[i]]; o[h][i] = (unsigned)(tok * K + C[i]) * 2u; }
                else o[h][i] = (unsigned)((h * HALF + R[i]) * K + C[i]) * 2u;
            }
    }
};

template <bool FP8 = false, class Epi, class Sched>
DI void gemm_phase(LAS unsigned char* lds, const Sched& S, const Epi& E, int sw = 0x7f7f7f7f, int sa = 0x7f7f7f7f) {
    const int tid = opaque_v(threadIdx.x), wid = __builtin_amdgcn_readfirstlane(tid >> 6), lane = tid & 63, wr = wid >> 2, wc = wid & 3, fr = lane & 15, fq = lane >> 4;
    const int K = S.K, nt = K / BK;
    int RR[2], CC[2]; unsigned voffB[2];
#pragma unroll
    for (int i = 0; i < 2; ++i) { int R, C; stage_rc(tid * 16 + i * 8192, R, C); const int Rb = (R & ~31) + perm32(R & 31); RR[i] = R; CC[i] = C; voffB[i] = (unsigned)(Rb * K + C) * 2u; }
    const size_t kstep = (size_t)(BK * 2);
    const size_t hstep = (size_t)HALF * K * 2;
    const unsigned ldsw = (unsigned)wid * 1024u;
    const int aoff = lds_byte(wr * 64 + fr, fq * 8), boff = lds_byte(wc * 32 + fr, fq * 8);
#define PG8_SA(b, h) (((b) * 2 + (h)) * HTB)
#define PG8_SB(b, h) ((4 + (b) * 2 + (h)) * HTB)
#define PG8_STAGE(bufoff, gbase, voff) do { _Pragma("unroll") for (int _i = 0; _i < 2; ++_i) \
        __builtin_amdgcn_global_load_lds((const unsigned*)((const char*)(gbase) + (voff)[_i]), (LAS unsigned*)(lds + (bufoff) + ldsw + _i * 8192), 16, 0, 0); } while (0)
#define PG8_LDA(dst, b, h) do { _Pragma("unroll") for (int m = 0; m < 4; ++m) _Pragma("unroll") for (int k = 0; k < 2; ++k) dst[m][k] = *(const LAS bf16x8*)(lds + PG8_SA(b, h) + aoff + m * 2048 + k * 1024); } while (0)
#define PG8_LDB(dst, b, h) do { _Pragma("unroll") for (int n = 0; n < 2; ++n) _Pragma("unroll") for (int k = 0; k < 2; ++k) dst[n][k] = *(const LAS bf16x8*)(lds + PG8_SB(b, h) + boff + n * 2048 + k * 1024); } while (0)
#define PG8_CAT(x) __builtin_shufflevector(__builtin_bit_cast(v4i, x[0]), __builtin_bit_cast(v4i, x[1]), 0, 1, 2, 3, 4, 5, 6, 7)
#define PG8_MMA(ai, bj, At, Bt) do { __builtin_amdgcn_s_setprio(1); \
        if constexpr (FP8) { _Pragma("unroll") for (int m = 0; m < 4; ++m) _Pragma("unroll") for (int n = 0; n < 2; ++n) \
            asm volatile("v_mfma_scale_f32_16x16x128_f8f6f4 %0, %1, %2, %0, %3, %4 op_sel_hi:[0,0,0]" : "+v"(acc[ai][bj][m][n]) : "v"(PG8_CAT(Bt[n])), "v"(PG8_CAT(At[m])), "v"(sw), "v"(sa)); } \
        else { _Pragma("unroll") for (int m = 0; m < 4; ++m) _Pragma("unroll") for (int n = 0; n < 2; ++n) _Pragma("unroll") for (int k = 0; k < 2; ++k) \
            acc[ai][bj][m][n] = __builtin_amdgcn_mfma_f32_16x16x32_bf16(Bt[n][k], At[m][k], acc[ai][bj][m][n], 0, 0, 0); } \
        __builtin_amdgcn_s_setprio(0); } while (0)
#define PG8_WAIT_V(n) asm volatile("s_waitcnt vmcnt(" #n ")" ::: "memory")
#define PG8_WAIT_L(n) asm volatile("s_waitcnt lgkmcnt(" #n ")" ::: "memory")
#define PG8_BAR __builtin_amdgcn_s_barrier()
#define PG8_SCHED __builtin_amdgcn_sched_barrier(0)
    Unit cur, nxt; int ui = 0;
    if (!S.next(0, cur)) return;
    f32x4 acc[2][2][4][2];
#pragma unroll
    for (int a = 0; a < 2; ++a)
#pragma unroll
        for (int b = 0; b < 2; ++b)
#pragma unroll
            for (int m = 0; m < 4; ++m)
#pragma unroll
                for (int n = 0; n < 2; ++n) acc[a][b][m][n] = (f32x4){0.f, 0.f, 0.f, 0.f};
    bf16x8 At[4][2], B0[2][2], B1[2][2];
    const char* cA = S.a_base(cur); const char* cB = S.b_base(cur);
    unsigned oAc[2][2], oAn[2][2];
    S.a_offs(cur, RR, CC, oAc);
    PG8_STAGE(PG8_SB(0, 0), cB, voffB); PG8_STAGE(PG8_SB(0, 1), cB + hstep, voffB); PG8_STAGE(PG8_SA(0, 0), cA, oAc[0]); PG8_STAGE(PG8_SA(0, 1), cA, oAc[1]);
    if (wr == 1) PG8_BAR;
    PG8_WAIT_V(2); PG8_BAR;
    PG8_STAGE(PG8_SB(1, 0), cB + kstep, voffB); PG8_STAGE(PG8_SA(1, 0), cA + kstep, oAc[0]); PG8_STAGE(PG8_SB(1, 1), cB + hstep + kstep, voffB);
    PG8_WAIT_V(6); PG8_BAR;
    for (;;) {
        const bool has_next = S.next(ui + 1, nxt);
        const char* nA = has_next ? S.a_base(nxt) : cA; const char* nB = has_next ? S.b_base(nxt) : cB;
        if (has_next) S.a_offs(nxt, RR, CC, oAn);
        else {
#pragma unroll
            for (int h = 0; h < 2; ++h)
#pragma unroll
                for (int i = 0; i < 2; ++i) oAn[h][i] = oAc[h][i]; }
        for (int t = 0; t < nt; t += 2) {
            const bool last = (t == nt - 2);
            const char* a1 = cA + (size_t)(t + 1) * kstep;
            const char* a2 = last ? nA : cA + (size_t)(t + 2) * kstep; const char* b2 = last ? nB : cB + (size_t)(t + 2) * kstep;
            const char* a3 = a2 + kstep; const char* b3 = b2 + kstep;
            unsigned o2[2][2];
#pragma unroll
            for (int h = 0; h < 2; ++h)
#pragma unroll
                for (int i = 0; i < 2; ++i) o2[h][i] = last ? oAn[h][i] : oAc[h][i];
            PG8_LDB(B0, 0, 0); PG8_LDB(B1, 0, 1); PG8_SCHED; PG8_LDA(At, 0, 0); PG8_STAGE(PG8_SA(1, 1), a1, oAc[1]);
            PG8_WAIT_V(8); PG8_WAIT_L(0); PG8_BAR; PG8_MMA(0, 0, At, B0); PG8_MMA(0, 1, At, B1); PG8_BAR; PG8_SCHED;
            PG8_LDA(At, 0, 1); PG8_STAGE(PG8_SB(0, 0), b2, voffB); PG8_STAGE(PG8_SB(0, 1), b2 + hstep, voffB); PG8_STAGE(PG8_SA(0, 0), a2, o2[0]);
            PG8_WAIT_V(8); PG8_WAIT_L(0); PG8_BAR; PG8_MMA(1, 0, At, B0); PG8_MMA(1, 1, At, B1); PG8_BAR; PG8_SCHED;
            PG8_LDB(B0, 1, 0); PG8_LDB(B1, 1, 1); PG8_SCHED; PG8_LDA(At, 1, 0); PG8_STAGE(PG8_SA(0, 1), a2, o2[1]);
            PG8_WAIT_V(8); PG8_WAIT_L(0); PG8_BAR; PG8_MMA(0, 0, At, B0); PG8_MMA(0, 1, At, B1); PG8_BAR; PG8_SCHED;
            PG8_LDA(At, 1, 1); PG8_STAGE(PG8_SB(1, 0), b3, voffB); PG8_STAGE(PG8_SB(1, 1), b3 + hstep, voffB); PG8_STAGE(PG8_SA(1, 0), a3, o2[0]);
            PG8_WAIT_V(8); PG8_WAIT_L(0); PG8_BAR; PG8_MMA(1, 0, At, B0); PG8_MMA(1, 1, At, B1); PG8_BAR; PG8_SCHED;
        }
        if (wr == 0) PG8_BAR;
        if constexpr (FP8) asm volatile("s_nop 15\n\ts_nop 15" ::: "memory");
        E(acc, cur, wr, wc, fr, fq);
        if (!has_next) break;
#pragma unroll
        for (int a = 0; a < 2; ++a)
#pragma unroll
            for (int b = 0; b < 2; ++b)
#pragma unroll
                for (int m = 0; m < 4; ++m)
#pragma unroll
                    for (int n = 0; n < 2; ++n) acc[a][b][m][n] = (f32x4){0.f, 0.f, 0.f, 0.f};
        cur = nxt; cA = nA; cB = nB; ++ui;
#pragma unroll
        for (int h = 0; h < 2; ++h)
#pragma unroll
            for (int i = 0; i < 2; ++i) oAc[h][i] = oAn[h][i];
        if (wr == 1) PG8_BAR;
    }
    PG8_WAIT_V(0);
    PG8_BAR;
#undef PG8_SA
#undef PG8_SB
#undef PG8_STAGE
#undef PG8_LDA
#undef PG8_LDB
#undef PG8_MMA
#undef PG8_CAT
#undef PG8_WAIT_V
#undef PG8_WAIT_L
#undef PG8_BAR
#undef PG8_SCHED
}

#define EPI_ROWS_BEGIN  _Pragma("unroll") for (int ai = 0; ai < 2; ++ai) _Pragma("unroll") for (int m = 0; m < 4; ++m) { const int row = u.pm * BM + ai * HALF + wr * 64 + m * 16 + fr;
#define EPI_ROWS_END }

DI u32x4 pack8(f32x4 a, f32x4 b) { u32x4 w; w.x = pk2(a[0], a[1]); w.y = pk2(a[2], a[3]); w.z = pk2(b[0], b[1]); w.w = pk2(b[2], b[3]); return w; }

struct EpiInProj {
    unsigned char* ws; const float* bias; const float* lb;
    DI void operator()(const f32x4 (&acc)[2][2][4][2], const Unit& u, int wr, int wc, int fr, int fq) const {
        const int colt = u.pn * BM;
        int seg, cbase;
        if (colt < 1024) { seg = 0; cbase = colt; } else if (colt < 1280) { seg = 1; cbase = colt - 1024; } else if (colt < 1536) { seg = 2; cbase = colt - 1280; }
        else { seg = 3 + (colt - 1536) / 1024; cbase = (colt - 1536) % 1024; }
        size_t doff; int ld = 1024, act = 0;
        switch (seg) { case 0: doff = WS_QA; break; case 1: doff = WS_KA; ld = 256; break; case 2: doff = WS_VA; ld = 256; break; case 3: doff = WS_QR; act = 1; break;
                       case 4: doff = WS_LF; act = 3; break; case 5: doff = WS_IR; break; case 6: doff = WS_GR; act = 1; break; case 7: doff = WS_GA; act = 2; break; default: doff = WS_GT; act = 2; break; }
        bf16* dst = (bf16*)(ws + doff); float* lf = (float*)(ws + doff);
        const int cw = wc * 32 + 8 * fq;
        f32x4 bv[2][2], lbv[2][2];
#pragma unroll
        for (int bj = 0; bj < 2; ++bj)
#pragma unroll
            for (int n = 0; n < 2; ++n) { bv[bj][n] = *(const f32x4*)(bias + colt + bj * HALF + cw + 4 * n);
                lbv[bj][n] = (act == 3) ? *(const f32x4*)(lb + cbase + bj * HALF + cw + 4 * n) : (f32x4){0.f, 0.f, 0.f, 0.f}; }
        EPI_ROWS_BEGIN
#pragma unroll
            for (int bj = 0; bj < 2; ++bj) {
                f32x4 v[2] = {acc[ai][bj][m][0] + bv[bj][0], acc[ai][bj][m][1] + bv[bj][1]};
                const int c = cbase + bj * HALF + cw;
                if (act == 3) {
#pragma unroll
                    for (int n = 0; n < 2; ++n) {
#pragma unroll
                        for (int e = 0; e < 4; ++e) { const float x = v[n][e]; const float ls = fminf(x, 0.f) - __logf(1.f + __expf(-fabsf(x)));
                            const float l0 = lbv[bj][n][e]; v[n][e] = (l0 > 0.f) ? __logf(l0 + (1.f - l0) * __expf(ls)) : ls; }
                        *(f32x4*)(lf + (size_t)row * 1024 + c + 4 * n) = v[n]; }
                } else {
                    if (act == 1) {
#pragma unroll
                        for (int n = 0; n < 2; ++n)
#pragma unroll
                            for (int e = 0; e < 4; ++e) v[n][e] = fsilu(v[n][e]);
                    } else if (act == 2) {
#pragma unroll
                        for (int n = 0; n < 2; ++n)
#pragma unroll
                            for (int e = 0; e < 4; ++e) v[n][e] = fsigmoid(v[n][e]);
                    }
                    *(u32x4*)(dst + (size_t)row * ld + c) = pack8(v[0], v[1]);
                }
            }
        EPI_ROWS_END
    }
};
struct EpiF32 {
    float* O; int ld;
    DI void operator()(const f32x4 (&acc)[2][2][4][2], const Unit& u, int wr, int wc, int fr, int fq) const {
        const int c0 = u.pn * BM + wc * 32 + 8 * fq;
        EPI_ROWS_BEGIN
#pragma unroll
            for (int bj = 0; bj < 2; ++bj)
#pragma unroll
                for (int n = 0; n < 2; ++n) *(f32x4*)(O + (size_t)row * ld + c0 + bj * HALF + 4 * n) = acc[ai][bj][m][n];
        EPI_ROWS_END
    }
};
struct EpiBf16 {
    bf16* O; int ld;
    DI void operator()(const f32x4 (&acc)[2][2][4][2], const Unit& u, int wr, int wc, int fr, int fq) const {
        const int c0 = u.pn * BM + wc * 32 + 8 * fq;
        EPI_ROWS_BEGIN
#pragma unroll
            for (int bj = 0; bj < 2; ++bj) *(u32x4*)(O + (size_t)row * ld + c0 + bj * HALF) = pack8(acc[ai][bj][m][0], acc[ai][bj][m][1]);
        EPI_ROWS_END
    }
};
template <bool ADD> struct EpiGate {
    bf16* O; const bf16* gate;
    DI void operator()(const f32x4 (&acc)[2][2][4][2], const Unit& u, int wr, int wc, int fr, int fq) const {
        const int c0 = u.pn * BM + wc * 32 + 8 * fq;
        EPI_ROWS_BEGIN
#pragma unroll
            for (int bj = 0; bj < 2; ++bj) {
                const size_t off = (size_t)row * 1024 + c0 + bj * HALF;
                const u32x4 g = *(const u32x4*)(gate + off);
                f32x4 a = acc[ai][bj][m][0], b = acc[ai][bj][m][1];
                a[0] *= bflo(g.x); a[1] *= bfhi(g.x); a[2] *= bflo(g.y); a[3] *= bfhi(g.y); b[0] *= bflo(g.z); b[1] *= bfhi(g.z); b[2] *= bflo(g.w); b[3] *= bfhi(g.w);
                if (ADD) { const u32x4 o = *(const u32x4*)(O + off);
                    a[0] += bflo(o.x); a[1] += bfhi(o.x); a[2] += bflo(o.y); a[3] += bfhi(o.y); b[0] += bflo(o.z); b[1] += bfhi(o.z); b[2] += bflo(o.w); b[3] += bfhi(o.w); }
                *(u32x4*)(O + off) = pack8(a, b);
            }
        EPI_ROWS_END
    }
};
struct EpiSwiglu {
    bf16* O; int ld; int pn0;
    DI void operator()(const f32x4 (&acc)[2][2][4][2], const Unit& u, int wr, int wc, int fr, int fq) const {
        const int c0 = (u.pn - pn0) * HALF + wc * 32 + 8 * fq;
        EPI_ROWS_BEGIN
            f32x4 a, b;
#pragma unroll
            for (int e = 0; e < 4; ++e) { a[e] = fsilu(acc[ai][0][m][0][e]) * acc[ai][1][m][0][e]; b[e] = fsilu(acc[ai][0][m][1][e]) * acc[ai][1][m][1][e]; }
            *(u32x4*)(O + (size_t)row * ld + c0) = pack8(a, b);
        EPI_ROWS_END
    }
};
struct EpiSwigluF8 {
    unsigned char* O; int ld;
    DI void operator()(const f32x4 (&acc)[2][2][4][2], const Unit& u, int wr, int wc, int fr, int fq) const {
        const int c0 = u.pn * HALF + wc * 32 + 8 * fq;
        EPI_ROWS_BEGIN
            f32x4 a, b;
#pragma unroll
            for (int e = 0; e < 4; ++e) { a[e] = fsilu(acc[ai][0][m][0][e]) * acc[ai][1][m][0][e] * 8.f; b[e] = fsilu(acc[ai][0][m][1][e]) * acc[ai][1][m][1][e] * 8.f; }
            u32x2 w; w.x = pk4_fp8(a[0], a[1], a[2], a[3]); w.y = pk4_fp8(b[0], b[1], b[2], b[3]);
            *(u32x2*)(O + (size_t)row * ld + c0) = w;
        EPI_ROWS_END
    }
};
struct EpiRouterShared {
    float* rlog; bf16* sact;
    DI void operator()(const f32x4 (&acc)[2][2][4][2], const Unit& u, int wr, int wc, int fr, int fq) const {
        if (u.pn == 0) { EpiF32 e{rlog, 256}; e(acc, u, wr, wc, fr, fq); }
        else { EpiSwiglu e{sact, 256, 1}; e(acc, u, wr, wc, fr, fq); }
    }
};
}

#define XB_TMO      128
#define XB_XCNT(j)  (256  + 64 * (j))
#define XB_XSUB(j)  (1280 + 64 * (j))
#define XB_XGEN(j)  (2304 + 64 * (j))
#define XB_TOP      3328
#define XB_TOPGEN   3392
#define XCD_BAR_WORDS 3456
#define XB_SPIN_CAP (1u << 18)

__device__ __forceinline__ unsigned xb_ld(unsigned* p)              { return __hip_atomic_load(p, __ATOMIC_RELAXED, __HIP_MEMORY_SCOPE_AGENT); }
__device__ __forceinline__ unsigned xb_add(unsigned* p, unsigned v) { return __hip_atomic_fetch_add(p, v, __ATOMIC_RELAXED, __HIP_MEMORY_SCOPE_AGENT); }
__device__ __forceinline__ unsigned xb_xcc_id() { return (unsigned)__builtin_amdgcn_s_getreg((3 << 11) | 20) & 0xFu; }
#define XB_SPIN(cond, bar) do { unsigned _sp = 0; while (cond) { __builtin_amdgcn_s_sleep(1); \
    if ((++_sp & 255u) == 0u) { if (xb_ld(&(bar)[XB_TMO])) break; if (_sp > XB_SPIN_CAP) { atomicAdd(&(bar)[XB_TMO], 1u); break; } } } } while (0)

struct XcdBarrier { unsigned* bar; unsigned x; volatile LAS unsigned* st; };

__device__ __forceinline__ XcdBarrier xcd_barrier_post(unsigned* bar, volatile LAS unsigned* st) {
    XcdBarrier b; b.bar = bar; b.x = xb_xcc_id(); b.st = st;
    if (threadIdx.x == 0) (void)xb_add(&bar[XB_XCNT(b.x)], 1u);
    return b;
}
__device__ __forceinline__ void xcd_barrier_complete(unsigned* bar, unsigned x, unsigned& nloc, unsigned& nx) {
    const unsigned G = gridDim.x * gridDim.y * gridDim.z;
    unsigned sum, cnt, mine, sp = 0u;
    for (;;) {
        sum = 0u; cnt = 0u; mine = 0u;
#pragma unroll
        for (unsigned j = 0; j < 16; ++j) { const unsigned c = xb_ld(&bar[XB_XCNT(j)]); sum += c; cnt += (c > 0u) ? 1u : 0u; mine = (j == x) ? c : mine; }
        if (sum == G) break;
        __builtin_amdgcn_s_sleep(1);
        if ((++sp & 255u) == 0u) { if (xb_ld(&bar[XB_TMO])) break; if (sp > XB_SPIN_CAP) { atomicAdd(&bar[XB_TMO], 1u); break; } }
    }
    nloc = mine > 0u ? mine : 1u; nx = cnt > 0u ? cnt : 1u;
}
__device__ __forceinline__ void xcd_barrier(const XcdBarrier& b) {
    asm volatile("s_waitcnt vmcnt(0)" ::: "memory");
    __syncthreads();
    if (threadIdx.x == 0) {
        unsigned* bar = b.bar;
        __builtin_amdgcn_s_waitcnt(0);
        unsigned nloc = b.st[0], nx = b.st[1];
        if (nloc == 0u) { xcd_barrier_complete(bar, b.x, nloc, nx); b.st[0] = nloc; b.st[1] = nx; }
        const unsigned old = xb_add(&bar[XB_XSUB(b.x)], 1u);
        const unsigned gen = old / nloc;
        if (old + 1u == (gen + 1u) * nloc) {
            __builtin_amdgcn_fence(__ATOMIC_RELEASE, "agent");
            asm volatile("s_waitcnt vmcnt(0)" ::: "memory");
            const unsigned og = xb_add(&bar[XB_TOP], 1u);
            const unsigned tg = og / nx;
            if (og + 1u == (tg + 1u) * nx) xb_add(&bar[XB_TOPGEN], 1u);
            else XB_SPIN(xb_ld(&bar[XB_TOPGEN]) == tg, bar);
            __builtin_amdgcn_fence(__ATOMIC_ACQUIRE, "agent");
            xb_add(&bar[XB_XGEN(b.x)], 1u);
            asm volatile("s_waitcnt vmcnt(0)" ::: "memory");
        } else {
            XB_SPIN(xb_ld(&bar[XB_XGEN(b.x)]) == gen, bar);
            __builtin_amdgcn_fence(__ATOMIC_ACQUIRE, "agent");
            asm volatile("s_waitcnt vmcnt(0)" ::: "memory");
        }
    }
    __syncthreads();
}

struct Frame {
    LAS unsigned char* lds;
    int tid, lane, wave, vcu, G;
    unsigned char* ws;
};
struct Args { const float* in[21]; float* out; unsigned char* ws; int ph_lo, ph_hi; };
enum { I_X = 0, I_LNIN_G, I_LNIN_B, I_LB, I_WIN, I_BIN, I_SINK, I_RNG, I_WPA, I_WPR, I_WOUT, I_LN1G, I_LN1B, I_RW, I_RB, I_EGU, I_ED, I_SGU, I_SD, I_LN2G, I_LN2B };

DI void tr_item(const float* __restrict__ W, int ldw, int k0, int n0, bf16* dst, int ldd, int lane, LAS unsigned char* scr) {
    const float* src = W + (size_t)(k0 + 4 * (lane >> 4)) * ldw + n0 + 4 * (lane & 15);
    f32x4 v[4][4];
#pragma unroll
    for (int blk = 0; blk < 4; ++blk)
#pragma unroll
        for (int i = 0; i < 4; ++i) v[blk][i] = *(const f32x4*)(src + (size_t)(16 * blk + i) * ldw);
#pragma unroll
    for (int blk = 0; blk < 4; ++blk)
#pragma unroll
        for (int c = 0; c < 4; ++c) {
            const int nl = 4 * (lane & 15) + c, chunk = 2 * blk + (lane >> 5), half = (lane >> 4) & 1;
            u32x2 w; w.x = pk2(v[blk][0][c], v[blk][1][c]); w.y = pk2(v[blk][2][c], v[blk][3][c]);
            *(LAS u32x2*)(scr + nl * 128 + ((chunk ^ (lane & 7)) * 16) + half * 8) = w;
        }
    asm volatile("s_waitcnt lgkmcnt(0)" ::: "memory");
#pragma unroll
    for (int jj = 0; jj < 8; ++jj) {
        const int nl = (lane >> 3) + 8 * jj, c = lane & 7;
        const u32x4 o = *(const LAS u32x4*)(scr + nl * 128 + ((c ^ ((nl >> 2) & 7)) * 16));
        *(u32x4*)(dst + (size_t)nl * ldd + 8 * c) = o;
    }
    asm volatile("s_waitcnt lgkmcnt(0)" ::: "memory");
}
DI void tr_item8(const float* __restrict__ W, int ldw, int k0, int n0, unsigned char* dst, int ldd, int lane, LAS unsigned char* scr) {
    const float* src = W + (size_t)(k0 + 4 * (lane >> 4)) * ldw + n0 + 4 * (lane & 15);
    f32x4 v[4][4];
#pragma unroll
    for (int blk = 0; blk < 4; ++blk)
#pragma unroll
        for (int i = 0; i < 4; ++i) v[blk][i] = *(const f32x4*)(src + (size_t)(16 * blk + i) * ldw);
#pragma unroll
    for (int blk = 0; blk < 4; ++blk)
#pragma unroll
        for (int c = 0; c < 4; ++c) {
            const int nl = 4 * (lane & 15) + c;
            *(LAS unsigned*)(scr + nl * 64 + ((blk ^ (lane & 3)) * 16) + 4 * (lane >> 4)) = pk4_fp8(v[blk][0][c] * 64.f, v[blk][1][c] * 64.f, v[blk][2][c] * 64.f, v[blk][3][c] * 64.f);
        }
    asm volatile("s_waitcnt lgkmcnt(0)" ::: "memory");
#pragma unroll
    for (int jj = 0; jj < 4; ++jj) {
        const int nl = (lane >> 2) + 16 * jj, c = lane & 3;
        const u32x4 o = *(const LAS u32x4*)(scr + nl * 64 + ((c ^ ((nl >> 2) & 3)) * 16));
        *(u32x4*)(dst + (size_t)nl * ldd + 16 * c) = o;
    }
    asm volatile("s_waitcnt lgkmcnt(0)" ::: "memory");
}
DI int gu_row(int n) { const int j = n & 255, isu = n >> 8; return (j >> 7) * 256 + isu * 128 + (j & 127); }

DI void ln_row(f32x4 (&v)[4], const float* g, const float* b, float* o32, bf16* o16, unsigned char* o8, int lane) {
    float s = 0.f;
#pragma unroll
    for (int j = 0; j < 4; ++j) s += (v[j][0] + v[j][1]) + (v[j][2] + v[j][3]);
    const float mean = wave_sum(s) * (1.f / DM); float s2 = 0.f;
#pragma unroll
    for (int j = 0; j < 4; ++j) { v[j] = v[j] - mean; s2 += (v[j][0] * v[j][0] + v[j][1] * v[j][1]) + (v[j][2] * v[j][2] + v[j][3] * v[j][3]); }
    const float rstd = 1.f / sqrtf(wave_sum(s2) * (1.f / DM) + LN_EPS);
#pragma unroll
    for (int j = 0; j < 4; ++j) {
        const f32x4 gg = *(const f32x4*)(g + 4 * lane + 256 * j), bb = *(const f32x4*)(b + 4 * lane + 256 * j);
        const f32x4 y = v[j] * rstd * gg + bb;
        if (o32) *(f32x4*)(o32 + 4 * lane + 256 * j) = y;
        if (o16) { u32x2 w; w.x = pk2(y[0], y[1]); w.y = pk2(y[2], y[3]); *(u32x2*)(o16 + 4 * lane + 256 * j) = w; }
        if (o8) *(unsigned*)(o8 + 4 * lane + 256 * j) = pk4_fp8(y[0], y[1], y[2], y[3]);
    }
}

DI void prologue(Frame& F, const Args& A) {
    const int gw = F.vcu * NWAVES + F.wave, NGW = F.G * NWAVES, lane = F.lane;
    bf16* WIN = (bf16*)(F.ws + WS_WIN); bf16* WPA = (bf16*)(F.ws + WS_WPA); bf16* WPR = (bf16*)(F.ws + WS_WPR); bf16* WOUT = (bf16*)(F.ws + WS_WOUT);
    bf16* WRS = (bf16*)(F.ws + WS_WRS); bf16* WSD = (bf16*)(F.ws + WS_WSD); bf16* WEGU = (bf16*)(F.ws + WS_WEGU); bf16* WED = (bf16*)(F.ws + WS_WED);
    LAS unsigned char* scr = F.lds + F.wave * 8192;
    constexpr int N_GU = 512 * 128, N_ED = 512 * 64, N_SM = 2944, NITEMS = N_GU + N_ED + 2 * N_SM;
    for (int it0 = gw; it0 < NITEMS; it0 += NGW) {
        int it = it0;
        if (it < N_GU) { const int le = it >> 7, r = it & 127, kb = r >> 3, nb = r & 7, n0 = nb * 64;
            tr_item8(A.in[I_EGU] + (size_t)le * (1024 * 512), 512, kb * 64, n0, (unsigned char*)WEGU + (size_t)le * (512 * 1024) + (size_t)gu_row(n0) * 1024 + kb * 64, 1024, lane, scr); continue; }
        it -= N_GU;
        if (it < N_ED) { const int le = it >> 6, r = it & 63, kb = r >> 4, nb = r & 15, n0 = nb * 64;
            tr_item8(A.in[I_ED] + (size_t)le * (256 * 1024), 1024, kb * 64, n0, (unsigned char*)WED + (size_t)le * (1024 * 256) + (size_t)n0 * 256 + kb * 64, 256, lane, scr); continue; }
        it -= N_ED;
        const int l = it / N_SM; int r = it % N_SM;
        if (r < 1920) { const int kb = r / 120, nb = r % 120; tr_item8(A.in[I_WIN] + (size_t)l * (1024 * INW), INW, kb * 64, nb * 64, (unsigned char*)WIN + (size_t)l * (INW * 1024) + (size_t)(nb * 64) * 1024 + kb * 64, 1024, lane, scr); continue; }
        r -= 1920;
        if (r < 768) { const int w = r >> 8, q = r & 255, kb = q >> 4, nb = q & 15; const float* src = (w == 0 ? A.in[I_WPA] : (w == 1 ? A.in[I_WPR] : A.in[I_WOUT])) + (size_t)l * (1024 * 1024);
            bf16* dst = (w == 0 ? WPA : (w == 1 ? WPR : WOUT)) + (size_t)l * (1024 * 1024);
            tr_item(src, 1024, kb * 64, nb * 64, dst + (size_t)(nb * 64) * 1024 + kb * 64, 1024, lane, scr); continue; }
        r -= 768;
        if (r < 64) { const int kb = r >> 2, nb = r & 3; tr_item(A.in[I_RW] + (size_t)l * (1024 * 256), 256, kb * 64, nb * 64, WRS + (size_t)l * (768 * 1024) + (size_t)(nb * 64) * 1024 + kb * 64, 1024, lane, scr); continue; }
        r -= 64;
        if (r < 128) { const int kb = r >> 3, nb = r & 7, n0 = nb * 64; tr_item(A.in[I_SGU] + (size_t)l * (1024 * 512), 512, kb * 64, n0, WRS + (size_t)l * (768 * 1024) + (size_t)(256 + gu_row(n0)) * 1024 + kb * 64, 1024, lane, scr); continue; }
        r -= 128;
        { const int kb = r >> 4, nb = r & 15; tr_item(A.in[I_SD] + (size_t)l * (256 * 1024), 1024, kb * 64, nb * 64, WSD + (size_t)l * (1024 * 256) + (size_t)(nb * 64) * 256 + kb * 64, 256, lane, scr); }
    }
    float* H32 = (float*)(F.ws + WS_H32); unsigned char* H8 = F.ws + WS_H8;
    for (int m = gw; m < NTOK; m += NGW) {
        f32x4 v[4];
#pragma unroll
        for (int j = 0; j < 4; ++j) v[j] = *(const f32x4*)(A.in[I_X] + (size_t)m * DM + 4 * lane + 256 * j);
        ln_row(v, A.in[I_LNIN_G], A.in[I_LNIN_B], H32 + (size_t)m * DM, (bf16*)nullptr, H8 + (size_t)m * DM, lane);
    }
    float* LB = (float*)(F.ws + WS_LB);
    for (int i = blockIdx.x * NTHR + F.tid; i < 1024; i += F.G * NTHR) {
        const float a = A.in[I_LB][i], b = A.in[I_LB][1024 + i], mx = fmaxf(a, b), ea = __expf(a - mx), eb = __expf(b - mx);
        LB[i] = 0.f; LB[1024 + i] = eb / (ea + eb);
    }
    int* ROWTOK = (int*)(F.ws + WS_ROWTOK);
    for (int i = blockIdx.x * NTHR + F.tid; i < RPAD_MAX; i += F.G * NTHR) ROWTOK[i] = 0;
}

constexpr int ATT_VP = 196;
DI int crow(int reg, int h) { return (reg & 3) + 8 * (reg >> 2) + 4 * h; }
DI void attn_unit(Frame& F, int b, int c, int hk, const float* sinks) {
    const bf16* QA = (const bf16*)(F.ws + WS_QA); const bf16* KA = (const bf16*)(F.ws + WS_KA); const bf16* VA = (const bf16*)(F.ws + WS_VA); bf16* ATT = (bf16*)(F.ws + WS_ATT);
    LAS bf16* VT = (LAS bf16*)F.lds;
    const int lane = F.lane, w = F.wave, r = lane & 31, h = lane >> 5;
    const int nkc = (c < 2 ? c : 2) + 1, nkeys = nkc * 64, ktok0 = b * SEQ + (c - (nkc - 1)) * 64;
    __syncthreads();
    for (int ch = F.tid; ch < nkeys * 8; ch += NTHR) {
        const int key = ch >> 3, d0 = (ch & 7) * 8;
        const u32x4 v = *(const u32x4*)(VA + (size_t)(ktok0 + key) * 256 + hk * 64 + d0);
        const unsigned vv[4] = {v.x, v.y, v.z, v.w};
#pragma unroll
        for (int j = 0; j < 4; ++j) { VT[(d0 + 2 * j) * ATT_VP + key] = (bf16)(vv[j] & 0xffffu); VT[(d0 + 2 * j + 1) * ATT_VP + key] = (bf16)(vv[j] >> 16); }
    }
    __syncthreads();
    const int head = hk * 4 + (w >> 1), qtok = b * SEQ + c * 64 + (w & 1) * 32 + r;
    bf16x8 qf[4];
#pragma unroll
    for (int ks = 0; ks < 4; ++ks) qf[ks] = *(const bf16x8*)(QA + (size_t)qtok * 1024 + head * 64 + ks * 16 + 8 * h);
    f32x16 s[6];
#pragma unroll
    for (int kt = 0; kt < 6; ++kt) {
#pragma unroll
        for (int i = 0; i < 16; ++i) s[kt][i] = 0.f;
        if (kt < nkc * 2) {
#pragma unroll
            for (int ks = 0; ks < 4; ++ks) {
                const bf16x8 kf = *(const bf16x8*)(KA + (size_t)(ktok0 + kt * 32 + r) * 256 + hk * 64 + ks * 16 + 8 * h);
                s[kt] = __builtin_amdgcn_mfma_f32_32x32x16_bf16(kf, qf[ks], s[kt], 0, 0, 0);
            }
        }
    }
    const float sink = sinks[head];
    float mx = -INFINITY;
#pragma unroll
    for (int kt = 0; kt < 6; ++kt) if (kt < nkc * 2) {
#pragma unroll
        for (int i = 0; i < 16; ++i) mx = fmaxf(mx, s[kt][i]);
    }
    mx = fmaxf(mx, __shfl_xor(mx, 32));
    mx = fmaxf(mx * 0.125f, sink);
    float sum = 0.f;
#pragma unroll
    for (int kt = 0; kt < 6; ++kt) if (kt < nkc * 2) {
#pragma unroll
        for (int i = 0; i < 16; ++i) { const float p = __expf(s[kt][i] * 0.125f - mx); s[kt][i] = p; sum += p; }
    }
    sum += __shfl_xor(sum, 32);
    const float inv = 1.f / (sum + __expf(sink - mx));
    f32x16 o[2];
#pragma unroll
    for (int dt = 0; dt < 2; ++dt)
#pragma unroll
        for (int i = 0; i < 16; ++i) o[dt][i] = 0.f;
#pragma unroll
    for (int kt = 0; kt < 6; ++kt) if (kt < nkc * 2) {
#pragma unroll
        for (int st = 0; st < 2; ++st) {
            u32x4 pw; pw.x = pk2(s[kt][8 * st + 0], s[kt][8 * st + 1]); pw.y = pk2(s[kt][8 * st + 2], s[kt][8 * st + 3]); pw.z = pk2(s[kt][8 * st + 4], s[kt][8 * st + 5]); pw.w = pk2(s[kt][8 * st + 6], s[kt][8 * st + 7]);
            const bf16x8 ps = __builtin_bit_cast(bf16x8, pw);
#pragma unroll
            for (int dt = 0; dt < 2; ++dt) {
                const LAS bf16* vp = VT + (dt * 32 + r) * ATT_VP + kt * 32 + 16 * st + 4 * h;
                const s16x4 lo = *(const LAS s16x4*)vp, hi = *(const LAS s16x4*)(vp + 8);
                const bf16x8 vf = __builtin_shufflevector(lo, hi, 0, 1, 2, 3, 4, 5, 6, 7);
                o[dt] = __builtin_amdgcn_mfma_f32_32x32x16_bf16(vf, ps, o[dt], 0, 0, 0);
            }
        }
    }
    bf16* orow = ATT + (size_t)qtok * 1024 + head * 64;
#pragma unroll
    for (int dt = 0; dt < 2; ++dt)
#pragma unroll
        for (int g = 0; g < 4; ++g) { u32x2 wv; wv.x = pk2(o[dt][4 * g] * inv, o[dt][4 * g + 1] * inv); wv.y = pk2(o[dt][4 * g + 2] * inv, o[dt][4 * g + 3] * inv);
            *(u32x2*)(orow + dt * 32 + 8 * g + 4 * h) = wv; }
}

constexpr int SCN = 4, NSC = NCHUNK / SCN;
constexpr int HP = 136, HS = 72;
constexpr int HL_Q1 = 0, HL_Q2 = HL_Q1 + 64 * HP * 2, HL_K2 = HL_Q2 + 64 * HP * 2, HL_K3T = HL_K2 + 64 * HP * 2, HL_VT = HL_K3T + 128 * HS * 2, HL_A = HL_VT + 128 * HS * 2,
              HL_S = HL_A + 64 * HS * 2, HL_DEC = HL_S + 128 * HP * 2, HL_SSQ = HL_DEC + 512, HL_END = HL_SSQ + 1024;
static_assert(HL_END <= LDS_KEEP, "hgrn LDS");
DI bf16x8 lds_frag(const LAS bf16* p) { return *(const LAS bf16x8*)p; }
template <int MODE> DI void hgrn_unit(Frame& F, int b, int hh, int sc, const float* rng) {
    const bf16* QR = (const bf16*)(F.ws + WS_QR); const float* LF = (const float*)(F.ws + WS_LF); const bf16* IR = (const bf16*)(F.ws + WS_IR); const bf16* GR = (const bf16*)(F.ws + WS_GR);
    bf16* REC = (bf16*)(F.ws + WS_REC);
    float* SST = (float*)(F.ws + (MODE == 1 ? WS_SIN : WS_SST)) + (size_t)((b * 8 + hh) * NSC + sc) * (128 * 128); float* SDEC = (float*)(F.ws + WS_SDEC) + ((b * 8 + hh) * NSC + sc) * 128;
    LAS bf16* Q1 = (LAS bf16*)(F.lds + HL_Q1); LAS bf16* Q2 = (LAS bf16*)(F.lds + HL_Q2); LAS bf16* K2 = (LAS bf16*)(F.lds + HL_K2); LAS bf16* K3T = (LAS bf16*)(F.lds + HL_K3T);
    LAS bf16* VT = (LAS bf16*)(F.lds + HL_VT); LAS bf16* AL = (LAS bf16*)(F.lds + HL_A); LAS bf16* SL = (LAS bf16*)(F.lds + HL_S);
    LAS float* DEC = (LAS float*)(F.lds + HL_DEC); LAS float* SSQ = (LAS float*)(F.lds + HL_SSQ);
    const int lane = F.lane, w = F.wave, r = lane & 31, h = lane >> 5;
    const int tg = lane >> 3, cp = lane & 7, ch0 = 16 * w + 2 * cp;
    const int kt = w >> 1, vt0 = 2 * (w & 1);
    const int ovt = w & 3, ott = w >> 2;
    f32x16 S0, S1;
    __syncthreads();
    if (MODE == 1) {
#pragma unroll
        for (int i = 0; i < 16; ++i) { const size_t o = (size_t)(kt * 32 + crow(i, h)) * 128 + r; S0[i] = SST[o + vt0 * 32]; S1[i] = SST[o + (vt0 + 1) * 32]; }
#pragma unroll
        for (int g = 0; g < 4; ++g) {
            u32x2 w0, w1; w0.x = pk2(S0[4 * g], S0[4 * g + 1]); w0.y = pk2(S0[4 * g + 2], S0[4 * g + 3]); w1.x = pk2(S1[4 * g], S1[4 * g + 1]); w1.y = pk2(S1[4 * g + 2], S1[4 * g + 3]);
            *(LAS u32x2*)(SL + (vt0 * 32 + r) * HP + kt * 32 + 8 * g + 4 * h) = w0;
            *(LAS u32x2*)(SL + ((vt0 + 1) * 32 + r) * HP + kt * 32 + 8 * g + 4 * h) = w1;
        }
    } else {
#pragma unroll
        for (int i = 0; i < 16; ++i) { S0[i] = 0.f; S1[i] = 0.f; }
    }
    float ng[16];
    if (MODE == 1) {
#pragma unroll
        for (int i = 0; i < 16; ++i) ng[i] = rng[ovt * 32 + crow(i, h)];
    }
    f32x2 dsum = {0.f, 0.f};
    f32x2 lf[8]; unsigned qv[8], vv[8];
    {   const size_t tok0 = (size_t)b * SEQ + (size_t)(sc * SCN) * 64;
#pragma unroll
        for (int j = 0; j < 8; ++j) { const size_t o = (tok0 + 8 * tg + j) * 1024 + hh * 128 + ch0;
            lf[j] = *(const f32x2*)(LF + o); vv[j] = *(const unsigned*)(IR + o); if (MODE == 1) qv[j] = *(const unsigned*)(QR + o); } }
    for (int cc = 0; cc < SCN; ++cc) {
        const size_t tok0 = (size_t)b * SEQ + (size_t)(sc * SCN + cc) * 64;
        {
            f32x2 bcum[8]; f32x2 run = {0.f, 0.f};
#pragma unroll
            for (int j = 0; j < 8; ++j) { run = run + lf[j]; bcum[j] = run; }
            f32x2 incl = run;
#pragma unroll
            for (int d = 8; d < 64; d <<= 1) { const float u0 = __shfl_up(incl[0], d), u1 = __shfl_up(incl[1], d); if (lane >= d) { incl[0] += u0; incl[1] += u1; } }
            const f32x2 excl = incl - run;
            f32x2 bend, bmid; bend[0] = __shfl(incl[0], 56 + cp); bend[1] = __shfl(incl[1], 56 + cp); bmid[0] = __shfl(incl[0], 24 + cp); bmid[1] = __shfl(incl[1], 24 + cp);
            dsum = dsum + bend;
            unsigned k3a[4], k3b[4]; float k3p[2];
#pragma unroll
            for (int j = 0; j < 8; ++j) {
                const f32x2 bb = bcum[j] + excl;
                const float kk0 = 1.f - __expf(lf[j][0]), kk1 = 1.f - __expf(lf[j][1]);
                const int t = 8 * tg + j;
                if (MODE == 1) {
                    const float q0 = bflo(qv[j]), q1 = bfhi(qv[j]);
                    *(LAS unsigned*)(Q1 + t * HP + ch0) = pk2(q0 * __expf(bb[0]), q1 * __expf(bb[1]));
                    *(LAS unsigned*)(Q2 + t * HP + ch0) = pk2(q0 * __expf(bb[0] - bmid[0]), q1 * __expf(bb[1] - bmid[1]));
                    *(LAS unsigned*)(K2 + t * HP + ch0) = pk2(kk0 * __expf(bmid[0] - bb[0]), kk1 * __expf(bmid[1] - bb[1]));
                }
                const float e0 = kk0 * __expf(bend[0] - bb[0]), e1 = kk1 * __expf(bend[1] - bb[1]);
                if (j & 1) { k3a[j >> 1] = pk2(k3p[0], e0); k3b[j >> 1] = pk2(k3p[1], e1); } else { k3p[0] = e0; k3p[1] = e1; }
            }
            *(LAS u32x4*)(K3T + ch0 * HS + 8 * tg) = (u32x4){k3a[0], k3a[1], k3a[2], k3a[3]};
            *(LAS u32x4*)(K3T + (ch0 + 1) * HS + 8 * tg) = (u32x4){k3b[0], k3b[1], k3b[2], k3b[3]};
            u32x4 va, vb;
            va.x = (vv[0] & 0xffffu) | (vv[1] << 16); va.y = (vv[2] & 0xffffu) | (vv[3] << 16); va.z = (vv[4] & 0xffffu) | (vv[5] << 16); va.w = (vv[6] & 0xffffu) | (vv[7] << 16);
            vb.x = (vv[0] >> 16) | (vv[1] & 0xffff0000u); vb.y = (vv[2] >> 16) | (vv[3] & 0xffff0000u); vb.z = (vv[4] >> 16) | (vv[5] & 0xffff0000u); vb.w = (vv[6] >> 16) | (vv[7] & 0xffff0000u);
            *(LAS u32x4*)(VT + ch0 * HS + 8 * tg) = va;
            *(LAS u32x4*)(VT + (ch0 + 1) * HS + 8 * tg) = vb;
            if (tg == 0) { DEC[ch0] = __expf(bend[0]); DEC[ch0 + 1] = __expf(bend[1]); }
        }
        if (cc + 1 < SCN) {
            const size_t tokn = tok0 + 64;
#pragma unroll
            for (int j = 0; j < 8; ++j) { const size_t o = (tokn + 8 * tg + j) * 1024 + hh * 128 + ch0;
                lf[j] = *(const f32x2*)(LF + o); vv[j] = *(const unsigned*)(IR + o); if (MODE == 1) qv[j] = *(const unsigned*)(QR + o); }
        }
        __syncthreads();
        f32x16 o;
        if (MODE == 1) {
            if (w < 3) {
                const int stl = (w == 2) ? 1 : 0, ttl = (w == 0) ? 0 : 1;
                f32x16 a;
#pragma unroll
                for (int i = 0; i < 16; ++i) a[i] = 0.f;
#pragma unroll
                for (int ks = 0; ks < 8; ++ks) {
                    const bf16x8 af = lds_frag(K2 + (stl * 32 + r) * HP + ks * 16 + 8 * h), bf = lds_frag(Q2 + (ttl * 32 + r) * HP + ks * 16 + 8 * h);
                    a = __builtin_amdgcn_mfma_f32_32x32x16_bf16(af, bf, a, 0, 0, 0);
                }
                const int t = ttl * 32 + r;
#pragma unroll
                for (int g = 0; g < 4; ++g) {
                    float x[4];
#pragma unroll
                    for (int e = 0; e < 4; ++e) { const int s = stl * 32 + 8 * g + 4 * h + e; x[e] = (s <= t) ? a[4 * g + e] : 0.f; }
                    u32x2 wv; wv.x = pk2(x[0], x[1]); wv.y = pk2(x[2], x[3]);
                    *(LAS u32x2*)(AL + t * HS + stl * 32 + 8 * g + 4 * h) = wv;
                }
            }
            __syncthreads();
#pragma unroll
            for (int i = 0; i < 16; ++i) o[i] = 0.f;
#pragma unroll
            for (int ks = 0; ks < 8; ++ks) {
                const bf16x8 af = lds_frag(SL + (ovt * 32 + r) * HP + ks * 16 + 8 * h), bf = lds_frag(Q1 + (ott * 32 + r) * HP + ks * 16 + 8 * h);
                o = __builtin_amdgcn_mfma_f32_32x32x16_bf16(af, bf, o, 0, 0, 0);
            }
#pragma unroll
            for (int ks = 0; ks < 4; ++ks) if (ks < 2 * (ott + 1)) {
                const bf16x8 af = lds_frag(VT + (ovt * 32 + r) * HS + ks * 16 + 8 * h), bf = lds_frag(AL + (ott * 32 + r) * HS + ks * 16 + 8 * h);
                o = __builtin_amdgcn_mfma_f32_32x32x16_bf16(af, bf, o, 0, 0, 0);
            }
            {   float ss = 0.f;
#pragma unroll
                for (int i = 0; i < 16; ++i) ss += o[i] * o[i];
                ss += __shfl_xor(ss, 32);
                if (h == 0) SSQ[ovt * 64 + ott * 32 + r] = ss;
            }
            __syncthreads();
        }
        {
#pragma unroll
            for (int i = 0; i < 16; ++i) { const float d = DEC[kt * 32 + crow(i, h)]; S0[i] *= d; S1[i] *= d; }
#pragma unroll
            for (int ks = 0; ks < 4; ++ks) {
                const bf16x8 af = lds_frag(K3T + (kt * 32 + r) * HS + ks * 16 + 8 * h);
                const bf16x8 b0 = lds_frag(VT + (vt0 * 32 + r) * HS + ks * 16 + 8 * h), b1 = lds_frag(VT + ((vt0 + 1) * 32 + r) * HS + ks * 16 + 8 * h);
                S0 = __builtin_amdgcn_mfma_f32_32x32x16_bf16(af, b0, S0, 0, 0, 0);
                S1 = __builtin_amdgcn_mfma_f32_32x32x16_bf16(af, b1, S1, 0, 0, 0);
            }
            if (MODE == 1) {
#pragma unroll
                for (int g = 0; g < 4; ++g) {
                    u32x2 w0, w1; w0.x = pk2(S0[4 * g], S0[4 * g + 1]); w0.y = pk2(S0[4 * g + 2], S0[4 * g + 3]); w1.x = pk2(S1[4 * g], S1[4 * g + 1]); w1.y = pk2(S1[4 * g + 2], S1[4 * g + 3]);
                    *(LAS u32x2*)(SL + (vt0 * 32 + r) * HP + kt * 32 + 8 * g + 4 * h) = w0;
                    *(LAS u32x2*)(SL + ((vt0 + 1) * 32 + r) * HP + kt * 32 + 8 * g + 4 * h) = w1;
                }
                const int t = ott * 32 + r;
                const float ms = (SSQ[t] + SSQ[64 + t] + SSQ[128 + t] + SSQ[192 + t]) * (1.f / 128.f);
                const float rstd = 1.f / sqrtf(ms + RMS_EPS);
                const size_t ob = (tok0 + t) * 1024 + hh * 128 + ovt * 32;
#pragma unroll
                for (int g = 0; g < 4; ++g) {
                    const u32x2 gg = *(const u32x2*)(GR + ob + 8 * g + 4 * h);
                    const float y0 = o[4 * g] * rstd * ng[4 * g] * bflo(gg.x), y1 = o[4 * g + 1] * rstd * ng[4 * g + 1] * bfhi(gg.x);
                    const float y2 = o[4 * g + 2] * rstd * ng[4 * g + 2] * bflo(gg.y), y3 = o[4 * g + 3] * rstd * ng[4 * g + 3] * bfhi(gg.y);
                    u32x2 wv; wv.x = pk2(y0, y1); wv.y = pk2(y2, y3);
                    *(u32x2*)(REC + ob + 8 * g + 4 * h) = wv;
                }
            }
        }
        __syncthreads();
    }
    if (MODE == 0) {
#pragma unroll
        for (int i = 0; i < 16; ++i) { const size_t o = (size_t)(kt * 32 + crow(i, h)) * 128 + r; SST[o + vt0 * 32] = S0[i]; SST[o + (vt0 + 1) * 32] = S1[i]; }
        if (tg == 0) { SDEC[ch0] = __expf(dsum[0]); SDEC[ch0 + 1] = __expf(dsum[1]); }
    }
}
DI void hgrn_scan_phase(Frame& F) {
    const float* SST = (const float*)(F.ws + WS_SST); float* SIN = (float*)(F.ws + WS_SIN); const float* SDEC = (const float*)(F.ws + WS_SDEC);
    const int gt = F.vcu * NTHR + F.tid, NT = F.G * NTHR;
    for (int q = gt; q < NB * 8 * 4096; q += NT) {
        const int bh = q >> 12, e4 = q & 4095, k = e4 >> 5, v4 = (e4 & 31) * 4;
        const size_t po = (size_t)bh * NSC * (128 * 128) + (size_t)k * 128 + v4; const float* p = SST + po; float* po_ = SIN + po; const float* dp = SDEC + bh * NSC * 128 + k;
        f32x4 R = {0.f, 0.f, 0.f, 0.f};
#pragma unroll 8
        for (int sc = 0; sc < NSC; ++sc) { const f32x4 loc = *(const f32x4*)(p + (size_t)sc * (128 * 128)); const float d = dp[sc * 128]; *(f32x4*)(po_ + (size_t)sc * (128 * 128)) = R; R = R * d + loc; }
    }
}

DI void ln_resid_phase(Frame& F, const float* g, const float* b) {
    const int gw = F.vcu * NWAVES + F.wave, NGW = F.G * NWAVES, lane = F.lane;
    const float* H32 = (const float*)(F.ws + WS_H32); float* H32B = (float*)(F.ws + WS_H32B); bf16* HB = (bf16*)(F.ws + WS_HB); const float* Y32 = (const float*)(F.ws + WS_Y32);
    for (int m = gw; m < NTOK; m += NGW) {
        f32x4 v[4];
#pragma unroll
        for (int j = 0; j < 4; ++j) { const size_t o = (size_t)m * DM + 4 * lane + 256 * j; v[j] = *(const f32x4*)(H32 + o) * ALPHA + *(const f32x4*)(Y32 + o); }
        ln_row(v, g, b, H32B + (size_t)m * DM, HB + (size_t)m * DM, F.ws + WS_H8 + (size_t)m * DM, lane);
    }
}

DI void moe_topk_phase(Frame& F, const float* rbias, unsigned* counts) {
    const float* RLOG = (const float*)(F.ws + WS_RLOG); int* TIDX = (int*)(F.ws + WS_TIDX); float* TGATE = (float*)(F.ws + WS_TGATE);
    LAS int* hist = (LAS int*)(F.lds + LDS_KEEP);
    const int lane = F.lane, tid = F.tid, half = lane >> 5;
    const int tpw = (NTOK + F.G - 1) / F.G, t0 = blockIdx.x * tpw, t1 = (t0 + tpw < NTOK) ? t0 + tpw : NTOK;
    if (tid < 256) hist[tid] = 0;
    __syncthreads();
    float bias[4];
#pragma unroll
    for (int j = 0; j < 4; ++j) bias[j] = rbias[lane + 64 * j];
    for (int t = t0 + F.wave; t < t1; t += NWAVES) {
        float sc[4]; unsigned key[4];
#pragma unroll
        for (int j = 0; j < 4; ++j) { sc[j] = 1.f / (1.f + __expf(-RLOG[(size_t)t * 256 + lane + 64 * j])); key[j] = (f2key(sc[j] + bias[j]) & 0xffffff00u) | (unsigned)(255 - (lane + 64 * j)); }
        float gs[8];
#pragma unroll
        for (int j = 0; j < 4; ++j) {
            unsigned a0, a1, b0, b1; half_umax(key[j], a0, a1);
            const unsigned mine = half ? a1 : a0;
            half_umax(key[j] == mine ? 0u : key[j], b0, b1);
            gs[2 * j] = key2f(a0 & 0xffffff00u) + key2f(b0 & 0xffffff00u); gs[2 * j + 1] = key2f(a1 & 0xffffff00u) + key2f(b1 & 0xffffff00u);
        }
        unsigned gsel = 0;
#pragma unroll
        for (int a = 0; a < 8; ++a) { int rank = 0;
#pragma unroll
            for (int q = 0; q < 8; ++q) rank += (gs[q] > gs[a] || (gs[q] == gs[a] && q < a)) ? 1 : 0;
            if (rank < 4) gsel |= 1u << a; }
#pragma unroll
        for (int j = 0; j < 4; ++j) if (!((gsel >> (2 * j + half)) & 1u)) key[j] = 0u;
        int myidx = 0; float mysc = 0.f, ssum = 0.f;
#pragma unroll
        for (int k = 0; k < TOPK; ++k) {
            const unsigned l01 = key[0] > key[1] ? key[0] : key[1], l23 = key[2] > key[3] ? key[2] : key[3];
            const unsigned win = wave_umax(l01 > l23 ? l01 : l23);
            const int e = 255 - (int)(win & 255u), oj = e >> 6, ol = e & 63;
            float s_w;
            const float scj = (oj == 0) ? sc[0] : (oj == 1) ? sc[1] : (oj == 2) ? sc[2] : sc[3];
            s_w = __uint_as_float((unsigned)__builtin_amdgcn_readlane((int)__float_as_uint(scj), ol));
#pragma unroll
            for (int j = 0; j < 4; ++j) if (key[j] == win) key[j] = 0u;
            ssum += s_w;
            if (lane == k) { myidx = e; mysc = s_w; }
        }
        if (lane < TOPK) {
            const int rank = __hip_atomic_fetch_add(&hist[myidx], 1, __ATOMIC_RELAXED, __HIP_MEMORY_SCOPE_WORKGROUP);
            TIDX[(size_t)t * TOPK + lane] = myidx | (rank << 8);
            TGATE[(size_t)t * TOPK + lane] = mysc / ssum * 2.5f;
        }
    }
    __syncthreads();
    if (tid < 256) ((int*)(F.ws + WS_MISC))[4096 + blockIdx.x * 256 + tid] = (int)atomicAdd(&counts[tid], (unsigned)hist[tid]);
}
DI void moe_scatter_phase(Frame& F, const unsigned* counts) {
    const int* TIDX = (const int*)(F.ws + WS_TIDX); int* TPOS = (int*)(F.ws + WS_TPOS); int* ROWTOK = (int*)(F.ws + WS_ROWTOK); int* MISC = (int*)(F.ws + WS_MISC);
    LAS int* hist = (LAS int*)(F.lds + LDS_KEEP); LAS int* wgbase = hist + 256; LAS int* padstart = hist + 512;
    const int tid = F.tid;
    const int tpw = (NTOK + F.G - 1) / F.G, t0 = blockIdx.x * tpw, t1 = (t0 + tpw < NTOK) ? t0 + tpw : NTOK;
    if (tid < 256) { hist[tid] = (int)((__hip_atomic_load(counts + tid, __ATOMIC_RELAXED, __HIP_MEMORY_SCOPE_AGENT) + 255u) & ~255u); wgbase[tid] = MISC[4096 + blockIdx.x * 256 + tid]; }
    __syncthreads();
    if (tid < 256) { int s = 0; for (int e = 0; e < tid; ++e) s += hist[e]; padstart[tid] = s;
        if (blockIdx.x == 0) { for (int tl = s >> 8; tl < (s + hist[tid]) >> 8; ++tl) MISC[tl] = tid; if (tid == 255) MISC[2047] = (s + hist[tid]) >> 8; } }
    __syncthreads();
    for (int i = t0 * TOPK + tid; i < t1 * TOPK; i += NTHR) {
        const int v = TIDX[i], e = v & 255, rank = v >> 8;
        const int pos = padstart[e] + wgbase[e] + rank;
        TPOS[i] = pos; ROWTOK[pos] = i >> 3;
    }
}
DI void moe_combine_phase(Frame& F, const float* g, const float* b, float* outp) {
    const int gw = F.vcu * NWAVES + F.wave, NGW = F.G * NWAVES, lane = F.lane;
    float* H32 = (float*)(F.ws + WS_H32); const float* H32B = (const float*)(F.ws + WS_H32B); bf16* HB = (bf16*)(F.ws + WS_HB); const float* Y32 = (const float*)(F.ws + WS_Y32);
    const bf16* YS = (const bf16*)(F.ws + WS_YS); const int* TPOS = (const int*)(F.ws + WS_TPOS); const float* TGATE = (const float*)(F.ws + WS_TGATE);
    for (int m = gw; m < NTOK; m += NGW) {
        f32x4 v[4];
#pragma unroll
        for (int j = 0; j < 4; ++j) { const size_t o = (size_t)m * DM + 4 * lane + 256 * j; v[j] = *(const f32x4*)(H32B + o) * ALPHA + *(const f32x4*)(Y32 + o); }
#pragma unroll
        for (int k = 0; k < TOPK; ++k) {
            const int pos = TPOS[(size_t)m * TOPK + k]; const float gk = TGATE[(size_t)m * TOPK + k];
#pragma unroll
            for (int j = 0; j < 4; ++j) { const u32x2 y = *(const u32x2*)(YS + (size_t)pos * DM + 4 * lane + 256 * j);
                v[j][0] += gk * bflo(y.x); v[j][1] += gk * bfhi(y.x); v[j][2] += gk * bflo(y.y); v[j][3] += gk * bfhi(y.y); }
        }
        ln_row(v, g, b, outp ? outp + (size_t)m * DM : H32 + (size_t)m * DM, (bf16*)nullptr, outp ? (unsigned char*)nullptr : F.ws + WS_H8 + (size_t)m * DM, lane);
    }
}

constexpr int PH_PER_LAYER = 13, N_PHASES = 1 + 2 * PH_PER_LAYER;
__global__ void __launch_bounds__(NTHR, 2) fwd_kernel(Args args) {
    extern __shared__ __attribute__((aligned(16))) unsigned char lds[];
    Frame F;
    F.lds = (LAS unsigned char*)lds;
    F.tid = threadIdx.x; F.lane = F.tid & 63; F.wave = __builtin_amdgcn_readfirstlane(F.tid >> 6);
    F.G = gridDim.x; { const int bx = blockIdx.x; F.vcu = (F.G % 8 == 0) ? (bx % 8) * (F.G / 8) + bx / 8 : bx; }
    F.ws = args.ws;
    unsigned* ctl = (unsigned*)(F.ws + WS_CTL);
    volatile LAS unsigned* MISCW = (volatile LAS unsigned*)(F.lds + MISC_OFF);
    if (F.tid < 32) MISCW[F.tid] = 0u;
    __syncthreads();
    const int lo = args.ph_lo, hi = args.ph_hi;
    XcdBarrier bar; bar.bar = ctl + CW_BAR; bar.x = 0; bar.st = MISCW + 8;
    if (hi - lo > 1) bar = xcd_barrier_post(ctl + CW_BAR, MISCW + 8);
#define IN(k) (lo <= (k) && (k) < hi)
#if defined(PROBE_A)
    unsigned long long t_prev = __builtin_amdgcn_s_memrealtime();
#define PROBE_STAMP(k) do { if (blockIdx.x == 0 && threadIdx.x == 0) { const unsigned long long t_now = __builtin_amdgcn_s_memrealtime(); const unsigned dt = (unsigned)(t_now - t_prev); t_prev = t_now; \
        if ((k) == PROBE_A) __hip_atomic_store(ctl + 8, dt, __ATOMIC_RELAXED, __HIP_MEMORY_SCOPE_AGENT); if ((k) == PROBE_B) __hip_atomic_store(ctl + 9, dt, __ATOMIC_RELAXED, __HIP_MEMORY_SCOPE_AGENT); } } while (0)
#else
#define PROBE_STAMP(k) do { } while (0)
#endif
#define SEAM(k) do { if (IN(k) && IN((k) + 1)) xcd_barrier(bar); PROBE_STAMP(k); } while (0)
#if defined(REP_K)
#define PH_REP(k) for (int _rep = 0, _n = ((k) == REP_K ? REP_N : 1); _rep < _n; ++_rep, (_rep < _n ? xcd_barrier(bar) : (void)0))
#else
#define PH_REP(k)
#endif

    if (IN(0)) PH_REP(0) { prologue(F, args); }
    SEAM(0);

#define PHASE_ENTER() do { F.ws = opaque_ptr(args.ws); F.tid = opaque_v(threadIdx.x); F.lane = F.tid & 63; F.wave = __builtin_amdgcn_readfirstlane(F.tid >> 6); } while (0)
    enum { P_INPROJ = 0, P_MIX_A, P_SCAN, P_MIX_C, P_PROJ, P_WOUT, P_LN1, P_ROUTER, P_TOPK, P_SCATTER, P_EXP_GU, P_EXP_DOWN, P_COMBINE };
    static_assert(P_COMBINE + 1 == PH_PER_LAYER, "phase count");
    for (int l = 0; l < 2; ++l) {
        const int pb = 1 + PH_PER_LAYER * l;
        if (IN(pb + P_INPROJ)) PH_REP(pb + P_INPROJ) { PHASE_ENTER();
            pg8::DenseSched S{(const bf16*)(F.ws + WS_H8), (const bf16*)(F.ws + WS_WIN) + (size_t)l * (INW * 512), 512, NTOK / 256, INW / 256, F.G, (int)blockIdx.x};
            pg8::EpiInProj E{F.ws, args.in[I_BIN] + (size_t)l * INW, (const float*)(F.ws + WS_LB) + l * 1024};
            pg8::gemm_phase<true>(F.lds, S, E, 0x79797979, 0x7f7f7f7f);
        }
        SEAM(pb + P_INPROJ);
        if (IN(pb + P_MIX_A)) PH_REP(pb + P_MIX_A) { PHASE_ENTER();
            for (int u = F.vcu; u < NB * NCHUNK * 4; u += F.G) { const int hk = u & 3, c = (u >> 2) % NCHUNK, b = u / (4 * NCHUNK); attn_unit(F, b, c, hk, args.in[I_SINK] + l * 16); }
            for (int u = F.vcu; u < NB * 8 * NSC; u += F.G) { const int sc = u % NSC, bh = u / NSC; hgrn_unit<0>(F, bh >> 3, bh & 7, sc, nullptr); }
        }
        SEAM(pb + P_MIX_A);
        if (IN(pb + P_SCAN)) PH_REP(pb + P_SCAN) { PHASE_ENTER(); hgrn_scan_phase(F); }
        SEAM(pb + P_SCAN);
        if (IN(pb + P_MIX_C)) PH_REP(pb + P_MIX_C) { PHASE_ENTER();
            for (int u = F.vcu; u < NB * 8 * NSC; u += F.G) { const int sc = u % NSC, bh = u / NSC; hgrn_unit<1>(F, bh >> 3, bh & 7, sc, args.in[I_RNG] + l * 128); }
        }
        SEAM(pb + P_MIX_C);
        if (IN(pb + P_PROJ)) PH_REP(pb + P_PROJ) { PHASE_ENTER();
            { pg8::DenseSched S{(const bf16*)(F.ws + WS_ATT), (const bf16*)(F.ws + WS_WPA) + (size_t)l * (1024 * 1024), 1024, NTOK / 256, 4, F.G, (int)blockIdx.x};
              pg8::EpiGate<false> E{(bf16*)(F.ws + WS_MRG), (const bf16*)(F.ws + WS_GA)}; pg8::gemm_phase(F.lds, S, E); }
            { pg8::DenseSched S{(const bf16*)(F.ws + WS_REC), (const bf16*)(F.ws + WS_WPR) + (size_t)l * (1024 * 1024), 1024, NTOK / 256, 4, F.G, (int)blockIdx.x};
              pg8::EpiGate<true> E{(bf16*)(F.ws + WS_MRG), (const bf16*)(F.ws + WS_GT)}; pg8::gemm_phase(F.lds, S, E); }
        }
        SEAM(pb + P_PROJ);
        if (IN(pb + P_WOUT)) PH_REP(pb + P_WOUT) { PHASE_ENTER();
            pg8::DenseSched S{(const bf16*)(F.ws + WS_MRG), (const bf16*)(F.ws + WS_WOUT) + (size_t)l * (1024 * 1024), 1024, NTOK / 256, 4, F.G, (int)blockIdx.x};
            pg8::EpiF32 E{(float*)(F.ws + WS_Y32), 1024}; pg8::gemm_phase(F.lds, S, E);
        }
        SEAM(pb + P_WOUT);
        if (IN(pb + P_LN1)) PH_REP(pb + P_LN1) { PHASE_ENTER(); ln_resid_phase(F, args.in[I_LN1G] + l * 1024, args.in[I_LN1B] + l * 1024); }
        SEAM(pb + P_LN1);
        if (IN(pb + P_ROUTER)) PH_REP(pb + P_ROUTER) { PHASE_ENTER();
            pg8::DenseSched S{(const bf16*)(F.ws + WS_HB), (const bf16*)(F.ws + WS_WRS) + (size_t)l * (768 * 1024), 1024, NTOK / 256, 3, F.G, (int)blockIdx.x};
            pg8::EpiRouterShared E{(float*)(F.ws + WS_RLOG), (bf16*)(F.ws + WS_SACT)}; pg8::gemm_phase(F.lds, S, E);
        }
        SEAM(pb + P_ROUTER);
        if (IN(pb + P_TOPK)) PH_REP(pb + P_TOPK) { PHASE_ENTER(); moe_topk_phase(F, args.in[I_RB] + l * 256, (unsigned*)(F.ws + WS_CTL) + CW_CNT + l * 256); }
        SEAM(pb + P_TOPK);
        if (IN(pb + P_SCATTER)) PH_REP(pb + P_SCATTER) { PHASE_ENTER(); moe_scatter_phase(F, (unsigned*)(F.ws + WS_CTL) + CW_CNT + l * 256); }
        SEAM(pb + P_SCATTER);
        if (IN(pb + P_EXP_GU)) PH_REP(pb + P_EXP_GU) { PHASE_ENTER();
            const int* MISC = (const int*)(F.ws + WS_MISC); const int ntiles = __builtin_amdgcn_readfirstlane(MISC[2047]);
            { pg8::GroupSched<true> S{(const bf16*)(F.ws + WS_H8), (const bf16*)(F.ws + WS_WEGU) + (size_t)l * 256 * (512 * 512), (const int*)(F.ws + WS_ROWTOK), MISC, 512, ntiles, 2, F.G, (int)blockIdx.x, (size_t)512 * 512};
              pg8::EpiSwigluF8 E{F.ws + WS_ACT, 256}; pg8::gemm_phase<true>(F.lds, S, E, 0x79797979, 0x7f7f7f7f); }
            { pg8::DenseSched S{(const bf16*)(F.ws + WS_SACT), (const bf16*)(F.ws + WS_WSD) + (size_t)l * (1024 * 256), 256, NTOK / 256, 4, F.G, (int)blockIdx.x};
              pg8::EpiF32 E{(float*)(F.ws + WS_Y32), 1024}; pg8::gemm_phase(F.lds, S, E); }
        }
        SEAM(pb + P_EXP_GU);
        if (IN(pb + P_EXP_DOWN)) PH_REP(pb + P_EXP_DOWN) { PHASE_ENTER();
            const int* MISC = (const int*)(F.ws + WS_MISC); const int ntiles = __builtin_amdgcn_readfirstlane(MISC[2047]);
            pg8::GroupSched<false> S{(const bf16*)(F.ws + WS_ACT), (const bf16*)(F.ws + WS_WED) + (size_t)l * 256 * (1024 * 128), nullptr, MISC, 128, ntiles, 4, F.G, (int)blockIdx.x, (size_t)1024 * 128};
            pg8::EpiBf16 E{(bf16*)(F.ws + WS_YS), 1024}; pg8::gemm_phase<true>(F.lds, S, E, 0x79797979, 0x7c7c7c7c);
        }
        SEAM(pb + P_EXP_DOWN);
        if (IN(pb + P_COMBINE)) PH_REP(pb + P_COMBINE) { PHASE_ENTER(); moe_combine_phase(F, args.in[I_LN2G] + l * 1024, args.in[I_LN2B] + l * 1024, l == 1 ? args.out : (float*)nullptr); }
        if (l == 0) SEAM(pb + P_COMBINE);
    }
#if defined(PROBE_A)
    xcd_barrier(bar); PROBE_STAMP(N_PHASES - 1);
    xcd_barrier(bar);
    {   const float ta = (float)__hip_atomic_load(ctl + 8, __ATOMIC_RELAXED, __HIP_MEMORY_SCOPE_AGENT) * 0.01f, tb = (float)__hip_atomic_load(ctl + 9, __ATOMIC_RELAXED, __HIP_MEMORY_SCOPE_AGENT) * 0.01f;
        const float va = sqrtf(ta);
        for (size_t i = (size_t)blockIdx.x * NTHR + threadIdx.x; i < (size_t)NTOK * DM; i += (size_t)gridDim.x * NTHR) args.out[i] = (i == 0) ? (100.f + tb) : va; }
#endif
#undef IN
#undef SEAM
}

#ifndef MK_PER_PHASE
#define MK_PER_PHASE 0
#endif
extern "C" void kernel_launch(void* const* d_in, const int* in_sizes, int n_in, void* d_out, int out_size, void* d_ws, size_t ws_size, hipStream_t stream) {
    static int grid = 0;
    if (grid == 0) {
        if (n_in != 21 || out_size != NTOK * DM || ws_size < WS_END) { fprintf(stderr, "kernel_launch: unexpected shapes (n_in %d out %d ws %zu)\n", n_in, out_size, ws_size); grid = -1; return; }
        int dev = 0, cus = 0, per_cu = 0;
        if (hipGetDevice(&dev) != hipSuccess || hipDeviceGetAttribute(&cus, hipDeviceAttributeMultiprocessorCount, dev) != hipSuccess) { grid = -1; return; }
        if (hipFuncSetAttribute((const void*)fwd_kernel, hipFuncAttributeMaxDynamicSharedMemorySize, LDS_BYTES) != hipSuccess) { fprintf(stderr, "kernel_launch: hipFuncSetAttribute failed\n"); grid = -1; return; }
        if (hipOccupancyMaxActiveBlocksPerMultiprocessor(&per_cu, (const void*)fwd_kernel, NTHR, LDS_BYTES) != hipSuccess || per_cu < 1) { fprintf(stderr, "kernel_launch: occupancy query says %d\n", per_cu); }
        (void)hipGetLastError();
        grid = cus;
    }
    if (grid < 0) return;
    (void)hipMemsetAsync((char*)d_ws + WS_CTL, 0, CTL_ZERO_BYTES, stream);
    Args a{};
    for (int i = 0; i < 21; ++i) a.in[i] = (const float*)d_in[i];
    a.out = (float*)d_out; a.ws = (unsigned char*)d_ws;
#if MK_PER_PHASE
    for (int p = 0; p < N_PHASES; ++p) { a.ph_lo = p; a.ph_hi = p + 1; hipLaunchKernelGGL(fwd_kernel, dim3(grid), dim3(NTHR), LDS_BYTES, stream, a); }
#else
    a.ph_lo = 0; a.ph_hi = N_PHASES; hipLaunchKernelGGL(fwd_kernel, dim3(grid), dim3(NTHR), LDS_BYTES, stream, a);
#endif
}
```

```cpp
#include <hip/hip_runtime.h>
#include <cstdio>
#include <cstdint>

#define GAS __attribute__((address_space(1)))
#define LAS __attribute__((address_space(3)))
typedef unsigned short bf16;
typedef short bf16x8 __attribute__((ext_vector_type(8)));
typedef short s16x4 __attribute__((ext_vector_type(4)));
typedef float f32x4 __attribute__((ext_vector_type(4)));
typedef float f32x2 __attribute__((ext_vector_type(2)));
typedef float f32x16 __attribute__((ext_vector_type(16)));
typedef unsigned u32x4 __attribute__((ext_vector_type(4)));
typedef unsigned u32x2 __attribute__((ext_vector_type(2)));
typedef __bf16 bf16x2_t __attribute__((ext_vector_type(2)));
typedef int v8i __attribute__((ext_vector_type(8)));
typedef int v4i __attribute__((ext_vector_type(4)));
#define DI __device__ __forceinline__

DI unsigned pk2(float lo, float hi) { f32x2 v = {lo, hi}; return __builtin_bit_cast(unsigned, __builtin_convertvector(v, bf16x2_t)); }
DI float clamp448(float x) { return __builtin_amdgcn_fmed3f(x, -448.f, 448.f); }
DI unsigned pk4_fp8(float a, float b, float c, float d) {
    int w = __builtin_amdgcn_cvt_pk_fp8_f32(clamp448(a), clamp448(b), 0, false);
    w = __builtin_amdgcn_cvt_pk_fp8_f32(clamp448(c), clamp448(d), w, true);
    return (unsigned)w;
}
DI float bflo(unsigned u) { return __uint_as_float(u << 16); }
DI float bfhi(unsigned u) { return __uint_as_float(u & 0xffff0000u); }
DI float bf2f(bf16 b) { return __uint_as_float((unsigned)b << 16); }
DI float fsigmoid(float x) { return __builtin_amdgcn_rcpf(1.f + __expf(-x)); }
DI float fsilu(float x) { return x * fsigmoid(x); }
DI unsigned char* opaque_ptr(unsigned char* p) { asm volatile("" : "+s"(p)); return p; }
DI int opaque_v(int v) { asm volatile("" : "+v"(v)); return v; }
DI int opaque_int(int v) { asm volatile("" : "+s"(v)); return v; }
template <int CTRL, int RM> DI unsigned dpp_umax(unsigned v) { const unsigned o = (unsigned)__builtin_amdgcn_update_dpp(0, (int)v, CTRL, RM, 0xf, false); return v > o ? v : o; }
DI void half_umax(unsigned v, unsigned& lo, unsigned& hi) {
    v = dpp_umax<0x111, 0xf>(v); v = dpp_umax<0x112, 0xf>(v); v = dpp_umax<0x114, 0xf>(v); v = dpp_umax<0x118, 0xf>(v);
    v = dpp_umax<0x142, 0xa>(v);
    lo = (unsigned)__builtin_amdgcn_readlane((int)v, 31); hi = (unsigned)__builtin_amdgcn_readlane((int)v, 63);
}
DI unsigned wave_umax(unsigned v) { unsigned lo, hi; half_umax(v, lo, hi); return lo > hi ? lo : hi; }
DI unsigned f2key(float f) { const unsigned u = __float_as_uint(f); return (u & 0x80000000u) ? ~u : (u | 0x80000000u); }
DI float key2f(unsigned k) { return __uint_as_float((k & 0x80000000u) ? (k & 0x7fffffffu) : ~k); }
DI float wave_sum(float v) {
#pragma unroll
    for (int o = 1; o < 64; o <<= 1) v += __shfl_xor(v, o);
    return v;
}

constexpr int NB = 4, SEQ = 8192, NTOK = NB * SEQ, DM = 1024, INW = 7680, NCHUNK = SEQ / 64;
constexpr int NE = 256, TOPK = 8, EFF = 256, RPAD_MAX = 1280 * 256;
constexpr float ALPHA = 1.4142135623730951f;
constexpr float LN_EPS = 1e-5f, RMS_EPS = 1e-5f;
constexpr int NWAVES = 8, NTHR = 512;

constexpr size_t MiB = 1u << 20;
constexpr size_t WS_CTL = 0, CTL_ZERO_BYTES = 1 * MiB;
constexpr size_t WS_WIN = 2 * MiB;
constexpr size_t WS_WPA = 34 * MiB;
constexpr size_t WS_WPR = 38 * MiB;
constexpr size_t WS_WOUT = 42 * MiB;
constexpr size_t WS_WRS = 46 * MiB;
constexpr size_t WS_WSD = 50 * MiB;
constexpr size_t WS_LB = 52 * MiB;
constexpr size_t WS_MISC = 53 * MiB;
constexpr size_t WS_WEGU = 64 * MiB;
constexpr size_t WS_WED = 576 * MiB;
constexpr size_t WS_HBA = 832 * MiB;
constexpr size_t WS_HB = 960 * MiB;
constexpr size_t WS_QA = 1024 * MiB, WS_KA = 1088 * MiB, WS_VA = 1104 * MiB, WS_QR = 1120 * MiB, WS_LF = 1184 * MiB, WS_IR = 1312 * MiB, WS_GR = 1376 * MiB, WS_GA = 1440 * MiB, WS_GT = 1504 * MiB;
constexpr size_t WS_ATT = 1568 * MiB, WS_REC = 1632 * MiB, WS_MRG = 1696 * MiB, WS_Y16 = 1760 * MiB;
constexpr size_t WS_RLOG = 1888 * MiB, WS_SACT = 1920 * MiB, WS_TIDX = 1936 * MiB, WS_TGATE = 1937 * MiB, WS_TPOS = 1938 * MiB, WS_ROWTOK = 1939 * MiB;
constexpr size_t WS_ACT = 1952 * MiB;
constexpr size_t WS_YS = 2112 * MiB;
constexpr size_t WS_SST = 2752 * MiB;
constexpr size_t WS_SDEC = 2816 * MiB;
constexpr size_t WS_H32B = 2818 * MiB;
constexpr size_t WS_SIN = 2946 * MiB;
constexpr size_t WS_H8 = 3010 * MiB;
constexpr size_t WS_END = 3042 * MiB;
constexpr int CW_BAR = 4096;
constexpr int CW_CNT = 16384;

constexpr int RING_BYTES = 131072;
constexpr int LDS_KEEP = 140 * 1024;
constexpr int MISC_OFF = 144 * 1024;
constexpr int LDS_BYTES = 147456;

namespace pg8 {
constexpr int BM = 256, BK = 64, HALF = 128, HTB = HALF * BK * 2, STAGE_BYTES = 8 * HTB, NXCD = 8, WGM = 8;
__host__ __device__ __forceinline__ int lds_byte(int r, int c) { const int st = (r >> 4) * 2 + (c >> 5), rr = r & 15, cc = c & 31, ob = rr * 64 + cc * 2; return st * 1024 + (ob ^ (((ob >> 9) & 1) << 5)); }
__host__ __device__ __forceinline__ void stage_rc(int b, int& R, int& C) { const int st = b / 1024, sb = b % 1024, swz = sb ^ (((sb >> 9) & 1) << 5); R = (st >> 1) * 16 + swz / 64; C = (st & 1) * 32 + (swz % 64) / 2; }
__host__ __device__ __forceinline__ int perm32(int rho) { const int n = rho >> 4, i = rho & 15; return 8 * (i >> 2) + 4 * n + (i & 3); }

struct Unit { int pm, pn, aux; };

DI bool static_unit(int i, int G, int c, int nM, int nN, Unit& u) {
    const int nwg = nM * nN; const long L = (long)i * G + c; if (L >= nwg) return false;
    int wgid = (int)L; { const int q = nwg / NXCD, r = nwg % NXCD, xcd = wgid % NXCD, off = wgid / NXCD; wgid = (xcd < r ? xcd * (q + 1) : r * (q + 1) + (xcd - r) * q) + off; }
    const int nig = WGM * nN, gid = wgid / nig, fm = gid * WGM, gsz = (nM - fm) < WGM ? (nM - fm) : WGM;
    u.pm = fm + ((wgid % nig) % gsz); u.pn = (wgid % nig) / gsz; u.aux = 0; return true;
}
struct DenseSched {
    const bf16* A; const bf16* Bt; int K, nM, nN, G, c;
    DI bool next(int i, Unit& u) const { return static_unit(i, G, c, nM, nN, u); }
    DI const char* a_base(const Unit& u) const { return (const char*)A + (size_t)u.pm * (size_t)(BM * K * 2); }
    DI const char* b_base(const Unit& u) const { return (const char*)Bt + (size_t)u.pn * (size_t)(BM * K * 2); }
    DI void a_offs(const Unit&, const int (&R)[2], const int (&C)[2], unsigned (&o)[2][2]) const {
#pragma unroll
        for (int h = 0; h < 2; ++h)
#pragma unroll
            for (int i = 0; i < 2; ++i) o[h][i] = (unsigned)((h * HALF + R[i]) * K + C[i]) * 2u;
    }
};
template <bool GATHER> struct GroupSched {
    const bf16* A; const bf16* Bt; const int* rowtok; const int* tile_e; int K, nM, nN, G, c; size_t bstride;
    DI bool next(int i, Unit& u) const { if (!static_unit(i, G, c, nM, nN, u)) return false; u.aux = __builtin_amdgcn_readfirstlane(tile_e[u.pm]); return true; }
    DI const char* a_base(const Unit& u) const { return GATHER ? (const char*)A : (const char*)A + (size_t)u.pm * (size_t)(BM * K * 2); }
    DI const char* b_base(const Unit& u) const { return (const char*)(Bt + (size_t)u.aux * bstride) + (size_t)u.pn * (size_t)(BM * K * 2); }
    DI void a_offs(const Unit& u, const int (&R)[2], const int (&C)[2], unsigned (&o)[2][2]) const {
#pragma unroll
        for (int h = 0; h < 2; ++h)
#pragma unroll
            for (int i = 0; i < 2; ++i) {
                if (GATHER) { const int tok = rowtok[u.pm * BM + h * HALF + R[i]]; o[h][i] = (unsigned)(tok * K + C[i]) * 2u; }
                else o[h][i] = (unsigned)((h * HALF + R[i]) * K + C[i]) * 2u;
            }
    }
};

template <bool FP8 = false, class Epi, class Sched>
DI void gemm_phase(LAS unsigned char* lds, const Sched& S, const Epi& E, int sw = 0x7f7f7f7f, int sa = 0x7f7f7f7f) {
    const int tid = opaque_v(threadIdx.x), wid = __builtin_amdgcn_readfirstlane(tid >> 6), lane = tid & 63, wr = wid >> 2, wc = wid & 3, fr = lane & 15, fq = lane >> 4;
    const int K = S.K, nt = K / BK;
    int RR[2], CC[2]; unsigned voffB[2];
#pragma unroll
    for (int i = 0; i < 2; ++i) { int R, C; stage_rc(tid * 16 + i * 8192, R, C); const int Rb = (R & ~31) + perm32(R & 31); RR[i] = R; CC[i] = C; voffB[i] = (unsigned)(Rb * K + C) * 2u; }
    const size_t kstep = (size_t)(BK * 2);
    const size_t hstep = (size_t)HALF * K * 2;
    const unsigned ldsw = (unsigned)wid * 1024u;
    const int aoff = lds_byte(wr * 64 + fr, fq * 8), boff = lds_byte(wc * 32 + fr, fq * 8);
#define PG8_SA(b, h) (((b) * 2 + (h)) * HTB)
#define PG8_SB(b, h) ((4 + (b) * 2 + (h)) * HTB)
#define PG8_STAGE(bufoff, gbase, voff) do { _Pragma("unroll") for (int _i = 0; _i < 2; ++_i) \
        __builtin_amdgcn_global_load_lds((const unsigned*)((const char*)(gbase) + (voff)[_i]), (LAS unsigned*)(lds + (bufoff) + ldsw + _i * 8192), 16, 0, 0); } while (0)
#define PG8_LDA(dst, b, h) do { _Pragma("unroll") for (int m = 0; m < 4; ++m) _Pragma("unroll") for (int k = 0; k < 2; ++k) dst[m][k] = *(const LAS bf16x8*)(lds + PG8_SA(b, h) + aoff + m * 2048 + k * 1024); } while (0)
#define PG8_LDB(dst, b, h) do { _Pragma("unroll") for (int n = 0; n < 2; ++n) _Pragma("unroll") for (int k = 0; k < 2; ++k) dst[n][k] = *(const LAS bf16x8*)(lds + PG8_SB(b, h) + boff + n * 2048 + k * 1024); } while (0)
#define PG8_CAT(x) __builtin_shufflevector(__builtin_bit_cast(v4i, x[0]), __builtin_bit_cast(v4i, x[1]), 0, 1, 2, 3, 4, 5, 6, 7)
#define PG8_MMA(ai, bj, At, Bt) do { __builtin_amdgcn_s_setprio(1); \
        if constexpr (FP8) { _Pragma("unroll") for (int m = 0; m < 4; ++m) _Pragma("unroll") for (int n = 0; n < 2; ++n) \
            asm volatile("v_mfma_scale_f32_16x16x128_f8f6f4 %0, %1, %2, %0, %3, %4 op_sel_hi:[0,0,0]" : "+v"(acc[ai][bj][m][n]) : "v"(PG8_CAT(Bt[n])), "v"(PG8_CAT(At[m])), "v"(sw), "v"(sa)); } \
        else { _Pragma("unroll") for (int m = 0; m < 4; ++m) _Pragma("unroll") for (int n = 0; n < 2; ++n) _Pragma("unroll") for (int k = 0; k < 2; ++k) \
            acc[ai][bj][m][n] = __builtin_amdgcn_mfma_f32_16x16x32_bf16(Bt[n][k], At[m][k], acc[ai][bj][m][n], 0, 0, 0); } \
        __builtin_amdgcn_s_setprio(0); } while (0)
#define PG8_WAIT_V(n) asm volatile("s_waitcnt vmcnt(" #n ")" ::: "memory")
#define PG8_WAIT_L(n) asm volatile("s_waitcnt lgkmcnt(" #n ")" ::: "memory")
#define PG8_BAR __builtin_amdgcn_s_barrier()
#define PG8_SCHED __builtin_amdgcn_sched_barrier(0)
    Unit cur, nxt; int ui = 0;
    if (!S.next(0, cur)) return;
    f32x4 acc[2][2][4][2];
#pragma unroll
    for (int a = 0; a < 2; ++a)
#pragma unroll
        for (int b = 0; b < 2; ++b)
#pragma unroll
            for (int m = 0; m < 4; ++m)
#pragma unroll
                for (int n = 0; n < 2; ++n) acc[a][b][m][n] = (f32x4){0.f, 0.f, 0.f, 0.f};
    bf16x8 At[4][2], B0[2][2], B1[2][2];
    const char* cA = S.a_base(cur); const char* cB = S.b_base(cur);
    unsigned oAc[2][2], oAn[2][2];
    S.a_offs(cur, RR, CC, oAc);
    PG8_STAGE(PG8_SB(0, 0), cB, voffB); PG8_STAGE(PG8_SB(0, 1), cB + hstep, voffB); PG8_STAGE(PG8_SA(0, 0), cA, oAc[0]); PG8_STAGE(PG8_SA(0, 1), cA, oAc[1]);
    if (wr == 1) PG8_BAR;
    PG8_WAIT_V(2); PG8_BAR;
    PG8_STAGE(PG8_SB(1, 0), cB + kstep, voffB); PG8_STAGE(PG8_SA(1, 0), cA + kstep, oAc[0]); PG8_STAGE(PG8_SB(1, 1), cB + hstep + kstep, voffB);
    PG8_WAIT_V(6); PG8_BAR;
    for (;;) {
        const bool has_next = S.next(ui + 1, nxt);
        const char* nA = has_next ? S.a_base(nxt) : cA; const char* nB = has_next ? S.b_base(nxt) : cB;
        if (has_next) S.a_offs(nxt, RR, CC, oAn);
        else {
#pragma unroll
            for (int h = 0; h < 2; ++h)
#pragma unroll
                for (int i = 0; i < 2; ++i) oAn[h][i] = oAc[h][i]; }
        for (int t = 0; t < nt; t += 2) {
            const bool last = (t == nt - 2);
            const char* a1 = cA + (size_t)(t + 1) * kstep;
            const char* a2 = last ? nA : cA + (size_t)(t + 2) * kstep; const char* b2 = last ? nB : cB + (size_t)(t + 2) * kstep;
            const char* a3 = a2 + kstep; const char* b3 = b2 + kstep;
            unsigned o2[2][2];
#pragma unroll
            for (int h = 0; h < 2; ++h)
#pragma unroll
                for (int i = 0; i < 2; ++i) o2[h][i] = last ? oAn[h][i] : oAc[h][i];
            PG8_LDB(B0, 0, 0); PG8_LDB(B1, 0, 1); PG8_SCHED; PG8_LDA(At, 0, 0); PG8_STAGE(PG8_SA(1, 1), a1, oAc[1]);
            PG8_WAIT_V(8); PG8_WAIT_L(0); PG8_BAR; PG8_MMA(0, 0, At, B0); PG8_MMA(0, 1, At, B1); PG8_BAR; PG8_SCHED;
            PG8_LDA(At, 0, 1); PG8_STAGE(PG8_SB(0, 0), b2, voffB); PG8_STAGE(PG8_SB(0, 1), b2 + hstep, voffB); PG8_STAGE(PG8_SA(0, 0), a2, o2[0]);
            PG8_WAIT_V(8); PG8_WAIT_L(0); PG8_BAR; PG8_MMA(1, 0, At, B0); PG8_MMA(1, 1, At, B1); PG8_BAR; PG8_SCHED;
            PG8_LDB(B0, 1, 0); PG8_LDB(B1, 1, 1); PG8_SCHED; PG8_LDA(At, 1, 0); PG8_STAGE(PG8_SA(0, 1), a2, o2[1]);
            PG8_WAIT_V(8); PG8_WAIT_L(0); PG8_BAR; PG8_MMA(0, 0, At, B0); PG8_MMA(0, 1, At, B1); PG8_BAR; PG8_SCHED;
            PG8_LDA(At, 1, 1); PG8_STAGE(PG8_SB(1, 0), b3, voffB); PG8_STAGE(PG8_SB(1, 1), b3 + hstep, voffB); PG8_STAGE(PG8_SA(1, 0), a3, o2[0]);
            PG8_WAIT_V(8); PG8_WAIT_L(0); PG8_BAR; PG8_MMA(1, 0, At, B0); PG8_MMA(1, 1, At, B1); PG8_BAR; PG8_SCHED;
        }
        if (wr == 0) PG8_BAR;
        if constexpr (FP8) asm volatile("s_nop 15\n\ts_nop 15" ::: "memory");
        E(acc, cur, wr, wc, fr, fq);
        if (!has_next) break;
#pragma unroll
        for (int a = 0; a < 2; ++a)
#pragma unroll
            for (int b = 0; b < 2; ++b)
#pragma unroll
                for (int m = 0; m < 4; ++m)
#pragma unroll
                    for (int n = 0; n < 2; ++n) acc[a][b][m][n] = (f32x4){0.f, 0.f, 0.f, 0.f};
        cur = nxt; cA = nA; cB = nB; ++ui;
#pragma unroll
        for (int h = 0; h < 2; ++h)
#pragma unroll
            for (int i = 0; i < 2; ++i) oAc[h][i] = oAn[h][i];
        if (wr == 1) PG8_BAR;
    }
    PG8_WAIT_V(0);
    PG8_BAR;
#undef PG8_SA
#undef PG8_SB
#undef PG8_STAGE
#undef PG8_LDA
#undef PG8_LDB
#undef PG8_MMA
#undef PG8_CAT
#undef PG8_WAIT_V
#undef PG8_WAIT_L
#undef PG8_BAR
#undef PG8_SCHED
}

#define EPI_ROWS_BEGIN  _Pragma("unroll") for (int ai = 0; ai < 2; ++ai) _Pragma("unroll") for (int m = 0; m < 4; ++m) { const int row = u.pm * BM + ai * HALF + wr * 64 + m * 16 + fr;
#define EPI_ROWS_END }

DI u32x4 pack8(f32x4 a, f32x4 b) { u32x4 w; w.x = pk2(a[0], a[1]); w.y = pk2(a[2], a[3]); w.z = pk2(b[0], b[1]); w.w = pk2(b[2], b[3]); return w; }

struct EpiInProj {
    unsigned char* ws; const float* bias; const float* lb;
    DI void operator()(const f32x4 (&acc)[2][2][4][2], const Unit& u, int wr, int wc, int fr, int fq) const {
        const int colt = u.pn * BM;
        int seg, cbase;
        if (colt < 1024) { seg = 0; cbase = colt; } else if (colt < 1280) { seg = 1; cbase = colt - 1024; } else if (colt < 1536) { seg = 2; cbase = colt - 1280; }
        else { seg = 3 + (colt - 1536) / 1024; cbase = (colt - 1536) % 1024; }
        size_t doff; int ld = 1024, act = 0;
        switch (seg) { case 0: doff = WS_QA; break; case 1: doff = WS_KA; ld = 256; break; case 2: doff = WS_VA; ld = 256; break; case 3: doff = WS_QR; act = 1; break;
                       case 4: doff = WS_LF; act = 3; break; case 5: doff = WS_IR; break; case 6: doff = WS_GR; act = 1; break; case 7: doff = WS_GA; act = 2; break; default: doff = WS_GT; act = 2; break; }
        bf16* dst = (bf16*)(ws + doff); float* lf = (float*)(ws + doff);
        const int cw = wc * 32 + 8 * fq;
        f32x4 bv[2][2], lbv[2][2];
#pragma unroll
        for (int bj = 0; bj < 2; ++bj)
#pragma unroll
            for (int n = 0; n < 2; ++n) { bv[bj][n] = *(const f32x4*)(bias + colt + bj * HALF + cw + 4 * n);
                lbv[bj][n] = (act == 3) ? *(const f32x4*)(lb + cbase + bj * HALF + cw + 4 * n) : (f32x4){0.f, 0.f, 0.f, 0.f}; }
        EPI_ROWS_BEGIN
#pragma unroll
            for (int bj = 0; bj < 2; ++bj) {
                f32x4 v[2] = {acc[ai][bj][m][0] + bv[bj][0], acc[ai][bj][m][1] + bv[bj][1]};
                const int c = cbase + bj * HALF + cw;
                if (act == 3) {
#pragma unroll
                    for (int n = 0; n < 2; ++n) {
#pragma unroll
                        for (int e = 0; e < 4; ++e) { const float x = v[n][e]; const float ls = fminf(x, 0.f) - __logf(1.f + __expf(-fabsf(x)));
                            const float l0 = lbv[bj][n][e]; v[n][e] = (l0 > 0.f) ? __logf(l0 + (1.f - l0) * __expf(ls)) : ls; }
                        *(f32x4*)(lf + (size_t)row * 1024 + c + 4 * n) = v[n]; }
                } else {
                    if (act == 1) {
#pragma unroll
                        for (int n = 0; n < 2; ++n)
#pragma unroll
                            for (int e = 0; e < 4; ++e) v[n][e] = fsilu(v[n][e]);
                    } else if (act == 2) {
#pragma unroll
                        for (int n = 0; n < 2; ++n)
#pragma unroll
                            for (int e = 0; e < 4; ++e) v[n][e] = fsigmoid(v[n][e]);
                    }
                    *(u32x4*)(dst + (size_t)row * ld + c) = pack8(v[0], v[1]);
                }
            }
        EPI_ROWS_END
    }
};
struct EpiF32 {
    float* O; int ld;
    DI void operator()(const f32x4 (&acc)[2][2][4][2], const Unit& u, int wr, int wc, int fr, int fq) const {
        const int c0 = u.pn * BM + wc * 32 + 8 * fq;
        EPI_ROWS_BEGIN
#pragma unroll
            for (int bj = 0; bj < 2; ++bj)
#pragma unroll
                for (int n = 0; n < 2; ++n) *(f32x4*)(O + (size_t)row * ld + c0 + bj * HALF + 4 * n) = acc[ai][bj][m][n];
        EPI_ROWS_END
    }
};
struct EpiBf16 {
    bf16* O; int ld;
    DI void operator()(const f32x4 (&acc)[2][2][4][2], const Unit& u, int wr, int wc, int fr, int fq) const {
        const int c0 = u.pn * BM + wc * 32 + 8 * fq;
        EPI_ROWS_BEGIN
#pragma unroll
            for (int bj = 0; bj < 2; ++bj) *(u32x4*)(O + (size_t)row * ld + c0 + bj * HALF) = pack8(acc[ai][bj][m][0], acc[ai][bj][m][1]);
        EPI_ROWS_END
    }
};
template <bool ADD> struct EpiGate {
    bf16* O; const bf16* gate;
    DI void operator()(const f32x4 (&acc)[2][2][4][2], const Unit& u, int wr, int wc, int fr, int fq) const {
        const int c0 = u.pn * BM + wc * 32 + 8 * fq;
        EPI_ROWS_BEGIN
#pragma unroll
            for (int bj = 0; bj < 2; ++bj) {
                const size_t off = (size_t)row * 1024 + c0 + bj * HALF;
                const u32x4 g = *(const u32x4*)(gate + off);
                f32x4 a = acc[ai][bj][m][0], b = acc[ai][bj][m][1];
                a[0] *= bflo(g.x); a[1] *= bfhi(g.x); a[2] *= bflo(g.y); a[3] *= bfhi(g.y); b[0] *= bflo(g.z); b[1] *= bfhi(g.z); b[2] *= bflo(g.w); b[3] *= bfhi(g.w);
                if (ADD) { const u32x4 o = *(const u32x4*)(O + off);
                    a[0] += bflo(o.x); a[1] += bfhi(o.x); a[2] += bflo(o.y); a[3] += bfhi(o.y); b[0] += bflo(o.z); b[1] += bfhi(o.z); b[2] += bflo(o.w); b[3] += bfhi(o.w); }
                *(u32x4*)(O + off) = pack8(a, b);
            }
        EPI_ROWS_END
    }
};
struct EpiSwiglu {
    bf16* O; int ld; int pn0;
    DI void operator()(const f32x4 (&acc)[2][2][4][2], const Unit& u, int wr, int wc, int fr, int fq) const {
        const int c0 = (u.pn - pn0) * HALF + wc * 32 + 8 * fq;
        EPI_ROWS_BEGIN
            f32x4 a, b;
#pragma unroll
            for (int e = 0; e < 4; ++e) { a[e] = fsilu(acc[ai][0][m][0][e]) * acc[ai][1][m][0][e]; b[e] = fsilu(acc[ai][0][m][1][e]) * acc[ai][1][m][1][e]; }
            *(u32x4*)(O + (size_t)row * ld + c0) = pack8(a, b);
        EPI_ROWS_END
    }
};
struct EpiSwigluF8 {
    unsigned char* O; int ld;
    DI void operator()(const f32x4 (&acc)[2][2][4][2], const Unit& u, int wr, int wc, int fr, int fq) const {
        const int c0 = u.pn * HALF + wc * 32 + 8 * fq;
        EPI_ROWS_BEGIN
            f32x4 a, b;
#pragma unroll
            for (int e = 0; e < 4; ++e) { a[e] = fsilu(acc[ai][0][m][0][e]) * acc[ai][1][m][0][e] * 8.f; b[e] = fsilu(acc[ai][0][m][1][e]) * acc[ai][1][m][1][e] * 8.f; }
            u32x2 w; w.x = pk4_fp8(a[0], a[1], a[2], a[3]); w.y = pk4_fp8(b[0], b[1], b[2], b[3]);
            *(u32x2*)(O + (size_t)row * ld + c0) = w;
        EPI_ROWS_END
    }
};
struct EpiRouterShared {
    float* rlog; bf16* sact;
    DI void operator()(const f32x4 (&acc)[2][2][4][2], const Unit& u, int wr, int wc, int fr, int fq) const {
        if (u.pn == 0) { EpiF32 e{rlog, 256}; e(acc, u, wr, wc, fr, fq); }
        else { EpiSwiglu e{sact, 256, 1}; e(acc, u, wr, wc, fr, fq); }
    }
};
}

#define XB_TMO      128
#define XB_XCNT(j)  (256  + 64 * (j))
#define XB_XSUB(j)  (1280 + 64 * (j))
#define XB_XGEN(j)  (2304 + 64 * (j))
#define XB_TOP      3328
#define XB_TOPGEN   3392
#define XCD_BAR_WORDS 3456
#define XB_SPIN_CAP (1u << 18)

__device__ __forceinline__ unsigned xb_ld(unsigned* p)              { return __hip_atomic_load(p, __ATOMIC_RELAXED, __HIP_MEMORY_SCOPE_AGENT); }
__device__ __forceinline__ unsigned xb_add(unsigned* p, unsigned v) { return __hip_atomic_fetch_add(p, v, __ATOMIC_RELAXED, __HIP_MEMORY_SCOPE_AGENT); }
__device__ __forceinline__ unsigned xb_xcc_id() { return (unsigned)__builtin_amdgcn_s_getreg((3 << 11) | 20) & 0xFu; }
#define XB_SPIN(cond, bar) do { unsigned _sp = 0; while (cond) { __builtin_amdgcn_s_sleep(1); \
    if ((++_sp & 255u) == 0u) { if (xb_ld(&(bar)[XB_TMO])) break; if (_sp > XB_SPIN_CAP) { atomicAdd(&(bar)[XB_TMO], 1u); break; } } } } while (0)

struct XcdBarrier { unsigned* bar; unsigned x; volatile LAS unsigned* st; };

__device__ __forceinline__ XcdBarrier xcd_barrier_post(unsigned* bar, volatile LAS unsigned* st) {
    XcdBarrier b; b.bar = bar; b.x = xb_xcc_id(); b.st = st;
    if (threadIdx.x == 0) (void)xb_add(&bar[XB_XCNT(b.x)], 1u);
    return b;
}
__device__ __forceinline__ void xcd_barrier_complete(unsigned* bar, unsigned x, unsigned& nloc, unsigned& nx) {
    const unsigned G = gridDim.x * gridDim.y * gridDim.z;
    unsigned sum, cnt, mine, sp = 0u;
    for (;;) {
        sum = 0u; cnt = 0u; mine = 0u;
#pragma unroll
        for (unsigned j = 0; j < 16; ++j) { const unsigned c = xb_ld(&bar[XB_XCNT(j)]); sum += c; cnt += (c > 0u) ? 1u : 0u; mine = (j == x) ? c : mine; }
        if (sum == G) break;
        __builtin_amdgcn_s_sleep(1);
        if ((++sp & 255u) == 0u) { if (xb_ld(&bar[XB_TMO])) break; if (sp > XB_SPIN_CAP) { atomicAdd(&bar[XB_TMO], 1u); break; } }
    }
    nloc = mine > 0u ? mine : 1u; nx = cnt > 0u ? cnt : 1u;
}
__device__ __forceinline__ void xcd_barrier(const XcdBarrier& b) {
    asm volatile("s_waitcnt vmcnt(0)" ::: "memory");
    __syncthreads();
    if (threadIdx.x == 0) {
        unsigned* bar = b.bar;
        __builtin_amdgcn_s_waitcnt(0);
        unsigned nloc = b.st[0], nx = b.st[1];
        if (nloc == 0u) { xcd_barrier_complete(bar, b.x, nloc, nx); b.st[0] = nloc; b.st[1] = nx; }
        const unsigned old = xb_add(&bar[XB_XSUB(b.x)], 1u);
        const unsigned gen = old / nloc;
        if (old + 1u == (gen + 1u) * nloc) {
            __builtin_amdgcn_fence(__ATOMIC_RELEASE, "agent");
            asm volatile("s_waitcnt vmcnt(0)" ::: "memory");
            const unsigned og = xb_add(&bar[XB_TOP], 1u);
            const unsigned tg = og / nx;
            if (og + 1u == (tg + 1u) * nx) xb_add(&bar[XB_TOPGEN], 1u);
            else XB_SPIN(xb_ld(&bar[XB_TOPGEN]) == tg, bar);
            __builtin_amdgcn_fence(__ATOMIC_ACQUIRE, "agent");
            xb_add(&bar[XB_XGEN(b.x)], 1u);
            asm volatile("s_waitcnt vmcnt(0)" ::: "memory");
        } else {
            XB_SPIN(xb_ld(&bar[XB_XGEN(b.x)]) == gen, bar);
            __builtin_amdgcn_fence(__ATOMIC_ACQUIRE, "agent");
            asm volatile("s_waitcnt vmcnt(0)" ::: "memory");
        }
    }
    __syncthreads();
}

struct Frame {
    LAS unsigned char* lds;
    int tid, lane, wave, vcu, G;
    unsigned char* ws;
};
struct Args { const float* in[21]; float* out; unsigned char* ws; int ph_lo, ph_hi; };
enum { I_X = 0, I_LNIN_G, I_LNIN_B, I_LB, I_WIN, I_BIN, I_SINK, I_RNG, I_WPA, I_WPR, I_WOUT, I_LN1G, I_LN1B, I_RW, I_RB, I_EGU, I_ED, I_SGU, I_SD, I_LN2G, I_LN2B };

DI void tr_item(const float* __restrict__ W, int ldw, int k0, int n0, bf16* dst, int ldd, int lane, LAS unsigned char* scr) {
    const float* src = W + (size_t)(k0 + 4 * (lane >> 4)) * ldw + n0 + 4 * (lane & 15);
    f32x4 v[4][4];
#pragma unroll
    for (int blk = 0; blk < 4; ++blk)
#pragma unroll
        for (int i = 0; i < 4; ++i) v[blk][i] = *(const f32x4*)(src + (size_t)(16 * blk + i) * ldw);
#pragma unroll
    for (int blk = 0; blk < 4; ++blk)
#pragma unroll
        for (int c = 0; c < 4; ++c) {
            const int nl = 4 * (lane & 15) + c, chunk = 2 * blk + (lane >> 5), half = (lane >> 4) & 1;
            u32x2 w; w.x = pk2(v[blk][0][c], v[blk][1][c]); w.y = pk2(v[blk][2][c], v[blk][3][c]);
            *(LAS u32x2*)(scr + nl * 128 + ((chunk ^ (lane & 7)) * 16) + half * 8) = w;
        }
    asm volatile("s_waitcnt lgkmcnt(0)" ::: "memory");
#pragma unroll
    for (int jj = 0; jj < 8; ++jj) {
        const int nl = (lane >> 3) + 8 * jj, c = lane & 7;
        const u32x4 o = *(const LAS u32x4*)(scr + nl * 128 + ((c ^ ((nl >> 2) & 7)) * 16));
        *(u32x4*)(dst + (size_t)nl * ldd + 8 * c) = o;
    }
    asm volatile("s_waitcnt lgkmcnt(0)" ::: "memory");
}
DI void tr_item8(const float* __restrict__ W, int ldw, int k0, int n0, unsigned char* dst, int ldd, int lane, LAS unsigned char* scr) {
    const float* src = W + (size_t)(k0 + 4 * (lane >> 4)) * ldw + n0 + 4 * (lane & 15);
    f32x4 v[4][4];
#pragma unroll
    for (int blk = 0; blk < 4; ++blk)
#pragma unroll
        for (int i = 0; i < 4; ++i) v[blk][i] = *(const f32x4*)(src + (size_t)(16 * blk + i) * ldw);
#pragma unroll
    for (int blk = 0; blk < 4; ++blk)
#pragma unroll
        for (int c = 0; c < 4; ++c) {
            const int nl = 4 * (lane & 15) + c;
            *(LAS unsigned*)(scr + nl * 64 + ((blk ^ (lane & 3)) * 16) + 4 * (lane >> 4)) = pk4_fp8(v[blk][0][c] * 64.f, v[blk][1][c] * 64.f, v[blk][2][c] * 64.f, v[blk][3][c] * 64.f);
        }
    asm volatile("s_waitcnt lgkmcnt(0)" ::: "memory");
#pragma unroll
    for (int jj = 0; jj < 4; ++jj) {
        const int nl = (lane >> 2) + 16 * jj, c = lane & 3;
        const u32x4 o = *(const LAS u32x4*)(scr + nl * 64 + ((c ^ ((nl >> 2) & 3)) * 16));
        *(u32x4*)(dst + (size_t)nl * ldd + 16 * c) = o;
    }
    asm volatile("s_waitcnt lgkmcnt(0)" ::: "memory");
}
DI int gu_row(int n) { const int j = n & 255, isu = n >> 8; return (j >> 7) * 256 + isu * 128 + (j & 127); }

DI void ln_row(f32x4 (&v)[4], const float* g, const float* b, float* o32, bf16* o16, unsigned char* o8, int lane) {
    float s = 0.f;
#pragma unroll
    for (int j = 0; j < 4; ++j) s += (v[j][0] + v[j][1]) + (v[j][2] + v[j][3]);
    const float mean = wave_sum(s) * (1.f / DM); float s2 = 0.f;
#pragma unroll
    for (int j = 0; j < 4; ++j) { v[j] = v[j] - mean; s2 += (v[j][0] * v[j][0] + v[j][1] * v[j][1]) + (v[j][2] * v[j][2] + v[j][3] * v[j][3]); }
    const float rstd = 1.f / sqrtf(wave_sum(s2) * (1.f / DM) + LN_EPS);
#pragma unroll
    for (int j = 0; j < 4; ++j) {
        const f32x4 gg = *(const f32x4*)(g + 4 * lane + 256 * j), bb = *(const f32x4*)(b + 4 * lane + 256 * j);
        const f32x4 y = v[j] * rstd * gg + bb;
        if (o32) *(f32x4*)(o32 + 4 * lane + 256 * j) = y;
        if (o16) { u32x2 w; w.x = pk2(y[0], y[1]); w.y = pk2(y[2], y[3]); *(u32x2*)(o16 + 4 * lane + 256 * j) = w; }
        if (o8) *(unsigned*)(o8 + 4 * lane + 256 * j) = pk4_fp8(y[0], y[1], y[2], y[3]);
    }
}

DI void prologue(Frame& F, const Args& A) {
    const int gw = F.vcu * NWAVES + F.wave, NGW = F.G * NWAVES, lane = F.lane;
    bf16* WIN = (bf16*)(F.ws + WS_WIN); bf16* WPA = (bf16*)(F.ws + WS_WPA); bf16* WPR = (bf16*)(F.ws + WS_WPR); bf16* WOUT = (bf16*)(F.ws + WS_WOUT);
    bf16* WRS = (bf16*)(F.ws + WS_WRS); bf16* WSD = (bf16*)(F.ws + WS_WSD); bf16* WEGU = (bf16*)(F.ws + WS_WEGU); bf16* WED = (bf16*)(F.ws + WS_WED);
    LAS unsigned char* scr = F.lds + F.wave * 8192;
    constexpr int N_GU = 512 * 128, N_ED = 512 * 64, N_SM = 2944, NITEMS = N_GU + N_ED + 2 * N_SM;
    for (int it0 = gw; it0 < NITEMS; it0 += NGW) {
        int it = it0;
        if (it < N_GU) { const int le = it >> 7, r = it & 127, kb = r >> 3, nb = r & 7, n0 = nb * 64;
            tr_item8(A.in[I_EGU] + (size_t)le * (1024 * 512), 512, kb * 64, n0, (unsigned char*)WEGU + (size_t)le * (512 * 1024) + (size_t)gu_row(n0) * 1024 + kb * 64, 1024, lane, scr); continue; }
        it -= N_GU;
        if (it < N_ED) { const int le = it >> 6, r = it & 63, kb = r >> 4, nb = r & 15, n0 = nb * 64;
            tr_item8(A.in[I_ED] + (size_t)le * (256 * 1024), 1024, kb * 64, n0, (unsigned char*)WED + (size_t)le * (1024 * 256) + (size_t)n0 * 256 + kb * 64, 256, lane, scr); continue; }
        it -= N_ED;
        const int l = it / N_SM; int r = it % N_SM;
        if (r < 1920) { const int kb = r / 120, nb = r % 120; tr_item8(A.in[I_WIN] + (size_t)l * (1024 * INW), INW, kb * 64, nb * 64, (unsigned char*)WIN + (size_t)l * (INW * 1024) + (size_t)(nb * 64) * 1024 + kb * 64, 1024, lane, scr); continue; }
        r -= 1920;
        if (r < 768) { const int w = r >> 8, q = r & 255, kb = q >> 4, nb = q & 15; const float* src = (w == 0 ? A.in[I_WPA] : (w == 1 ? A.in[I_WPR] : A.in[I_WOUT])) + (size_t)l * (1024 * 1024);
            bf16* dst = (w == 0 ? WPA : (w == 1 ? WPR : WOUT)) + (size_t)l * (1024 * 1024);
            tr_item(src, 1024, kb * 64, nb * 64, dst + (size_t)(nb * 64) * 1024 + kb * 64, 1024, lane, scr); continue; }
        r -= 768;
        if (r < 64) { const int kb = r >> 2, nb = r & 3; tr_item(A.in[I_RW] + (size_t)l * (1024 * 256), 256, kb * 64, nb * 64, WRS + (size_t)l * (768 * 1024) + (size_t)(nb * 64) * 1024 + kb * 64, 1024, lane, scr); continue; }
        r -= 64;
        if (r < 128) { const int kb = r >> 3, nb = r & 7, n0 = nb * 64; tr_item(A.in[I_SGU] + (size_t)l * (1024 * 512), 512, kb * 64, n0, WRS + (size_t)l * (768 * 1024) + (size_t)(256 + gu_row(n0)) * 1024 + kb * 64, 1024, lane, scr); continue; }
        r -= 128;
        { const int kb = r >> 4, nb = r & 15; tr_item(A.in[I_SD] + (size_t)l * (256 * 1024), 1024, kb * 64, nb * 64, WSD + (size_t)l * (1024 * 256) + (size_t)(nb * 64) * 256 + kb * 64, 256, lane, scr); }
    }
    bf16* HBA = (bf16*)(F.ws + WS_HBA); unsigned char* H8 = F.ws + WS_H8;
    for (int m = gw; m < NTOK; m += NGW) {
        f32x4 v[4];
#pragma unroll
        for (int j = 0; j < 4; ++j) v[j] = *(const f32x4*)(A.in[I_X] + (size_t)m * DM + 4 * lane + 256 * j);
        ln_row(v, A.in[I_LNIN_G], A.in[I_LNIN_B], (float*)nullptr, HBA + (size_t)m * DM, H8 + (size_t)m * DM, lane);
    }
    float* LB = (float*)(F.ws + WS_LB);
    for (int i = blockIdx.x * NTHR + F.tid; i < 1024; i += F.G * NTHR) {
        const float a = A.in[I_LB][i], b = A.in[I_LB][1024 + i], mx = fmaxf(a, b), ea = __expf(a - mx), eb = __expf(b - mx);
        LB[i] = 0.f; LB[1024 + i] = eb / (ea + eb);
    }
    int* ROWTOK = (int*)(F.ws + WS_ROWTOK);
    for (int i = blockIdx.x * NTHR + F.tid; i < RPAD_MAX; i += F.G * NTHR) ROWTOK[i] = 0;
}

constexpr int ATT_VP = 196;
DI int crow(int reg, int h) { return (reg & 3) + 8 * (reg >> 2) + 4 * h; }
DI void attn_unit(Frame& F, int b, int c, int hk, const float* sinks) {
    const bf16* QA = (const bf16*)(F.ws + WS_QA); const bf16* KA = (const bf16*)(F.ws + WS_KA); const bf16* VA = (const bf16*)(F.ws + WS_VA); bf16* ATT = (bf16*)(F.ws + WS_ATT);
    LAS bf16* VT = (LAS bf16*)F.lds;
    const int lane = F.lane, w = F.wave, r = lane & 31, h = lane >> 5;
    const int nkc = (c < 2 ? c : 2) + 1, nkeys = nkc * 64, ktok0 = b * SEQ + (c - (nkc - 1)) * 64;
    __syncthreads();
    for (int ch = F.tid; ch < nkeys * 8; ch += NTHR) {
        const int key = ch >> 3, d0 = (ch & 7) * 8;
        const u32x4 v = *(const u32x4*)(VA + (size_t)(ktok0 + key) * 256 + hk * 64 + d0);
        const unsigned vv[4] = {v.x, v.y, v.z, v.w};
#pragma unroll
        for (int j = 0; j < 4; ++j) { VT[(d0 + 2 * j) * ATT_VP + key] = (bf16)(vv[j] & 0xffffu); VT[(d0 + 2 * j + 1) * ATT_VP + key] = (bf16)(vv[j] >> 16); }
    }
    __syncthreads();
    const int head = hk * 4 + (w >> 1), qtok = b * SEQ + c * 64 + (w & 1) * 32 + r;
    bf16x8 qf[4];
#pragma unroll
    for (int ks = 0; ks < 4; ++ks) qf[ks] = *(const bf16x8*)(QA + (size_t)qtok * 1024 + head * 64 + ks * 16 + 8 * h);
    f32x16 s[6];
#pragma unroll
    for (int kt = 0; kt < 6; ++kt) {
#pragma unroll
        for (int i = 0; i < 16; ++i) s[kt][i] = 0.f;
        if (kt < nkc * 2) {
#pragma unroll
            for (int ks = 0; ks < 4; ++ks) {
                const bf16x8 kf = *(const bf16x8*)(KA + (size_t)(ktok0 + kt * 32 + r) * 256 + hk * 64 + ks * 16 + 8 * h);
                s[kt] = __builtin_amdgcn_mfma_f32_32x32x16_bf16(kf, qf[ks], s[kt], 0, 0, 0);
            }
        }
    }
    const float sink = sinks[head];
    float mx = -INFINITY;
#pragma unroll
    for (int kt = 0; kt < 6; ++kt) if (kt < nkc * 2) {
#pragma unroll
        for (int i = 0; i < 16; ++i) mx = fmaxf(mx, s[kt][i]);
    }
    mx = fmaxf(mx, __shfl_xor(mx, 32));
    mx = fmaxf(mx * 0.125f, sink);
    float sum = 0.f;
#pragma unroll
    for (int kt = 0; kt < 6; ++kt) if (kt < nkc * 2) {
#pragma unroll
        for (int i = 0; i < 16; ++i) { const float p = __expf(s[kt][i] * 0.125f - mx); s[kt][i] = p; sum += p; }
    }
    sum += __shfl_xor(sum, 32);
    const float inv = 1.f / (sum + __expf(sink - mx));
    f32x16 o[2];
#pragma unroll
    for (int dt = 0; dt < 2; ++dt)
#pragma unroll
        for (int i = 0; i < 16; ++i) o[dt][i] = 0.f;
#pragma unroll
    for (int kt = 0; kt < 6; ++kt) if (kt < nkc * 2) {
#pragma unroll
        for (int st = 0; st < 2; ++st) {
            u32x4 pw; pw.x = pk2(s[kt][8 * st + 0], s[kt][8 * st + 1]); pw.y = pk2(s[kt][8 * st + 2], s[kt][8 * st + 3]); pw.z = pk2(s[kt][8 * st + 4], s[kt][8 * st + 5]); pw.w = pk2(s[kt][8 * st + 6], s[kt][8 * st + 7]);
            const bf16x8 ps = __builtin_bit_cast(bf16x8, pw);
#pragma unroll
            for (int dt = 0; dt < 2; ++dt) {
                const LAS bf16* vp = VT + (dt * 32 + r) * ATT_VP + kt * 32 + 16 * st + 4 * h;
                const s16x4 lo = *(const LAS s16x4*)vp, hi = *(const LAS s16x4*)(vp + 8);
                const bf16x8 vf = __builtin_shufflevector(lo, hi, 0, 1, 2, 3, 4, 5, 6, 7);
                o[dt] = __builtin_amdgcn_mfma_f32_32x32x16_bf16(vf, ps, o[dt], 0, 0, 0);
            }
        }
    }
    bf16* orow = ATT + (size_t)qtok * 1024 + head * 64;
#pragma unroll
    for (int dt = 0; dt < 2; ++dt)
#pragma unroll
        for (int g = 0; g < 4; ++g) { u32x2 wv; wv.x = pk2(o[dt][4 * g] * inv, o[dt][4 * g + 1] * inv); wv.y = pk2(o[dt][4 * g + 2] * inv, o[dt][4 * g + 3] * inv);
            *(u32x2*)(orow + dt * 32 + 8 * g + 4 * h) = wv; }
}

constexpr int SCN = 4, NSC = NCHUNK / SCN;
constexpr int HP = 136, HS = 72;
constexpr int HL_Q1 = 0, HL_Q2 = HL_Q1 + 64 * HP * 2, HL_K2 = HL_Q2 + 64 * HP * 2, HL_K3T = HL_K2 + 64 * HP * 2, HL_VT = HL_K3T + 128 * HS * 2, HL_A = HL_VT + 128 * HS * 2,
              HL_S = HL_A + 64 * HS * 2, HL_DEC = HL_S + 128 * HP * 2, HL_SSQ = HL_DEC + 512, HL_END = HL_SSQ + 1024;
static_assert(HL_END <= LDS_KEEP, "hgrn LDS");
DI bf16x8 lds_frag(const LAS bf16* p) { return *(const LAS bf16x8*)p; }
template <int MODE> DI void hgrn_unit(Frame& F, int b, int hh, int sc, const float* rng) {
    const bf16* QR = (const bf16*)(F.ws + WS_QR); const float* LF = (const float*)(F.ws + WS_LF); const bf16* IR = (const bf16*)(F.ws + WS_IR); const bf16* GR = (const bf16*)(F.ws + WS_GR);
    bf16* REC = (bf16*)(F.ws + WS_REC);
    float* SST = (float*)(F.ws + (MODE == 1 ? WS_SIN : WS_SST)) + (size_t)((b * 8 + hh) * NSC + sc) * (128 * 128); float* SDEC = (float*)(F.ws + WS_SDEC) + ((b * 8 + hh) * NSC + sc) * 128;
    LAS bf16* Q1 = (LAS bf16*)(F.lds + HL_Q1); LAS bf16* Q2 = (LAS bf16*)(F.lds + HL_Q2); LAS bf16* K2 = (LAS bf16*)(F.lds + HL_K2); LAS bf16* K3T = (LAS bf16*)(F.lds + HL_K3T);
    LAS bf16* VT = (LAS bf16*)(F.lds + HL_VT); LAS bf16* AL = (LAS bf16*)(F.lds + HL_A); LAS bf16* SL = (LAS bf16*)(F.lds + HL_S);
    LAS float* DEC = (LAS float*)(F.lds + HL_DEC); LAS float* SSQ = (LAS float*)(F.lds + HL_SSQ);
    const int lane = F.lane, w = F.wave, r = lane & 31, h = lane >> 5;
    const int tg = lane >> 3, cp = lane & 7, ch0 = 16 * w + 2 * cp;
    const int kt = w >> 1, vt0 = 2 * (w & 1);
    const int ovt = w & 3, ott = w >> 2;
    f32x16 S0, S1;
    __syncthreads();
    if (MODE == 1) {
#pragma unroll
        for (int i = 0; i < 16; ++i) { const size_t o = (size_t)(kt * 32 + crow(i, h)) * 128 + r; S0[i] = SST[o + vt0 * 32]; S1[i] = SST[o + (vt0 + 1) * 32]; }
#pragma unroll
        for (int g = 0; g < 4; ++g) {
            u32x2 w0, w1; w0.x = pk2(S0[4 * g], S0[4 * g + 1]); w0.y = pk2(S0[4 * g + 2], S0[4 * g + 3]); w1.x = pk2(S1[4 * g], S1[4 * g + 1]); w1.y = pk2(S1[4 * g + 2], S1[4 * g + 3]);
            *(LAS u32x2*)(SL + (vt0 * 32 + r) * HP + kt * 32 + 8 * g + 4 * h) = w0;
            *(LAS u32x2*)(SL + ((vt0 + 1) * 32 + r) * HP + kt * 32 + 8 * g + 4 * h) = w1;
        }
    } else {
#pragma unroll
        for (int i = 0; i < 16; ++i) { S0[i] = 0.f; S1[i] = 0.f; }
    }
    float ng[16];
    if (MODE == 1) {
#pragma unroll
        for (int i = 0; i < 16; ++i) ng[i] = rng[ovt * 32 + crow(i, h)];
    }
    f32x2 dsum = {0.f, 0.f};
    f32x2 lf[8]; unsigned qv[8], vv[8];
    {   const size_t tok0 = (size_t)b * SEQ + (size_t)(sc * SCN) * 64;
#pragma unroll
        for (int j = 0; j < 8; ++j) { const size_t o = (tok0 + 8 * tg + j) * 1024 + hh * 128 + ch0;
            lf[j] = *(const f32x2*)(LF + o); vv[j] = *(const unsigned*)(IR + o); if (MODE == 1) qv[j] = *(const unsigned*)(QR + o); } }
    for (int cc = 0; cc < SCN; ++cc) {
        const size_t tok0 = (size_t)b * SEQ + (size_t)(sc * SCN + cc) * 64;
        {
            f32x2 bcum[8]; f32x2 run = {0.f, 0.f};
#pragma unroll
            for (int j = 0; j < 8; ++j) { run = run + lf[j]; bcum[j] = run; }
            f32x2 incl = run;
#pragma unroll
            for (int d = 8; d < 64; d <<= 1) { const float u0 = __shfl_up(incl[0], d), u1 = __shfl_up(incl[1], d); if (lane >= d) { incl[0] += u0; incl[1] += u1; } }
            const f32x2 excl = incl - run;
            f32x2 bend, bmid; bend[0] = __shfl(incl[0], 56 + cp); bend[1] = __shfl(incl[1], 56 + cp); bmid[0] = __shfl(incl[0], 24 + cp); bmid[1] = __shfl(incl[1], 24 + cp);
            dsum = dsum + bend;
            unsigned k3a[4], k3b[4]; float k3p[2];
#pragma unroll
            for (int j = 0; j < 8; ++j) {
                const f32x2 bb = bcum[j] + excl;
                const float kk0 = 1.f - __expf(lf[j][0]), kk1 = 1.f - __expf(lf[j][1]);
                const int t = 8 * tg + j;
                if (MODE == 1) {
                    const float q0 = bflo(qv[j]), q1 = bfhi(qv[j]);
                    *(LAS unsigned*)(Q1 + t * HP + ch0) = pk2(q0 * __expf(bb[0]), q1 * __expf(bb[1]));
                    *(LAS unsigned*)(Q2 + t * HP + ch0) = pk2(q0 * __expf(bb[0] - bmid[0]), q1 * __expf(bb[1] - bmid[1]));
                    *(LAS unsigned*)(K2 + t * HP + ch0) = pk2(kk0 * __expf(bmid[0] - bb[0]), kk1 * __expf(bmid[1] - bb[1]));
                }
                const float e0 = kk0 * __expf(bend[0] - bb[0]), e1 = kk1 * __expf(bend[1] - bb[1]);
                if (j & 1) { k3a[j >> 1] = pk2(k3p[0], e0); k3b[j >> 1] = pk2(k3p[1], e1); } else { k3p[0] = e0; k3p[1] = e1; }
            }
            *(LAS u32x4*)(K3T + ch0 * HS + 8 * tg) = (u32x4){k3a[0], k3a[1], k3a[2], k3a[3]};
            *(LAS u32x4*)(K3T + (ch0 + 1) * HS + 8 * tg) = (u32x4){k3b[0], k3b[1], k3b[2], k3b[3]};
            u32x4 va, vb;
            va.x = (vv[0] & 0xffffu) | (vv[1] << 16); va.y = (vv[2] & 0xffffu) | (vv[3] << 16); va.z = (vv[4] & 0xffffu) | (vv[5] << 16); va.w = (vv[6] & 0xffffu) | (vv[7] << 16);
            vb.x = (vv[0] >> 16) | (vv[1] & 0xffff0000u); vb.y = (vv[2] >> 16) | (vv[3] & 0xffff0000u); vb.z = (vv[4] >> 16) | (vv[5] & 0xffff0000u); vb.w = (vv[6] >> 16) | (vv[7] & 0xffff0000u);
            *(LAS u32x4*)(VT + ch0 * HS + 8 * tg) = va;
            *(LAS u32x4*)(VT + (ch0 + 1) * HS + 8 * tg) = vb;
            if (tg == 0) { DEC[ch0] = __expf(bend[0]); DEC[ch0 + 1] = __expf(bend[1]); }
        }
        if (cc + 1 < SCN) {
            const size_t tokn = tok0 + 64;
#pragma unroll
            for (int j = 0; j < 8; ++j) { const size_t o = (tokn + 8 * tg + j) * 1024 + hh * 128 + ch0;
                lf[j] = *(const f32x2*)(LF + o); vv[j] = *(const unsigned*)(IR + o); if (MODE == 1) qv[j] = *(const unsigned*)(QR + o); }
        }
        __syncthreads();
        f32x16 o;
        if (MODE == 1) {
            if (w < 3) {
                const int stl = (w == 2) ? 1 : 0, ttl = (w == 0) ? 0 : 1;
                f32x16 a;
#pragma unroll
                for (int i = 0; i < 16; ++i) a[i] = 0.f;
#pragma unroll
                for (int ks = 0; ks < 8; ++ks) {
                    const bf16x8 af = lds_frag(K2 + (stl * 32 + r) * HP + ks * 16 + 8 * h), bf = lds_frag(Q2 + (ttl * 32 + r) * HP + ks * 16 + 8 * h);
                    a = __builtin_amdgcn_mfma_f32_32x32x16_bf16(af, bf, a, 0, 0, 0);
                }
                const int t = ttl * 32 + r;
#pragma unroll
                for (int g = 0; g < 4; ++g) {
                    float x[4];
#pragma unroll
                    for (int e = 0; e < 4; ++e) { const int s = stl * 32 + 8 * g + 4 * h + e; x[e] = (s <= t) ? a[4 * g + e] : 0.f; }
                    u32x2 wv; wv.x = pk2(x[0], x[1]); wv.y = pk2(x[2], x[3]);
                    *(LAS u32x2*)(AL + t * HS + stl * 32 + 8 * g + 4 * h) = wv;
                }
            }
            __syncthreads();
#pragma unroll
            for (int i = 0; i < 16; ++i) o[i] = 0.f;
#pragma unroll
            for (int ks = 0; ks < 8; ++ks) {
                const bf16x8 af = lds_frag(SL + (ovt * 32 + r) * HP + ks * 16 + 8 * h), bf = lds_frag(Q1 + (ott * 32 + r) * HP + ks * 16 + 8 * h);
                o = __builtin_amdgcn_mfma_f32_32x32x16_bf16(af, bf, o, 0, 0, 0);
            }
#pragma unroll
            for (int ks = 0; ks < 4; ++ks) if (ks < 2 * (ott + 1)) {
                const bf16x8 af = lds_frag(VT + (ovt * 32 + r) * HS + ks * 16 + 8 * h), bf = lds_frag(AL + (ott * 32 + r) * HS + ks * 16 + 8 * h);
                o = __builtin_amdgcn_mfma_f32_32x32x16_bf16(af, bf, o, 0, 0, 0);
            }
            {   float ss = 0.f;
#pragma unroll
                for (int i = 0; i < 16; ++i) ss += o[i] * o[i];
                ss += __shfl_xor(ss, 32);
                if (h == 0) SSQ[ovt * 64 + ott * 32 + r] = ss;
            }
            __syncthreads();
        }
        {
#pragma unroll
            for (int i = 0; i < 16; ++i) { const float d = DEC[kt * 32 + crow(i, h)]; S0[i] *= d; S1[i] *= d; }
#pragma unroll
            for (int ks = 0; ks < 4; ++ks) {
                const bf16x8 af = lds_frag(K3T + (kt * 32 + r) * HS + ks * 16 + 8 * h);
                const bf16x8 b0 = lds_frag(VT + (vt0 * 32 + r) * HS + ks * 16 + 8 * h), b1 = lds_frag(VT + ((vt0 + 1) * 32 + r) * HS + ks * 16 + 8 * h);
                S0 = __builtin_amdgcn_mfma_f32_32x32x16_bf16(af, b0, S0, 0, 0, 0);
                S1 = __builtin_amdgcn_mfma_f32_32x32x16_bf16(af, b1, S1, 0, 0, 0);
            }
            if (MODE == 1) {
#pragma unroll
                for (int g = 0; g < 4; ++g) {
                    u32x2 w0, w1; w0.x = pk2(S0[4 * g], S0[4 * g + 1]); w0.y = pk2(S0[4 * g + 2], S0[4 * g + 3]); w1.x = pk2(S1[4 * g], S1[4 * g + 1]); w1.y = pk2(S1[4 * g + 2], S1[4 * g + 3]);
                    *(LAS u32x2*)(SL + (vt0 * 32 + r) * HP + kt * 32 + 8 * g + 4 * h) = w0;
                    *(LAS u32x2*)(SL + ((vt0 + 1) * 32 + r) * HP + kt * 32 + 8 * g + 4 * h) = w1;
                }
                const int t = ott * 32 + r;
                const float ms = (SSQ[t] + SSQ[64 + t] + SSQ[128 + t] + SSQ[192 + t]) * (1.f / 128.f);
                const float rstd = 1.f / sqrtf(ms + RMS_EPS);
                const size_t ob = (tok0 + t) * 1024 + hh * 128 + ovt * 32;
#pragma unroll
                for (int g = 0; g < 4; ++g) {
                    const u32x2 gg = *(const u32x2*)(GR + ob + 8 * g + 4 * h);
                    const float y0 = o[4 * g] * rstd * ng[4 * g] * bflo(gg.x), y1 = o[4 * g + 1] * rstd * ng[4 * g + 1] * bfhi(gg.x);
                    const float y2 = o[4 * g + 2] * rstd * ng[4 * g + 2] * bflo(gg.y), y3 = o[4 * g + 3] * rstd * ng[4 * g + 3] * bfhi(gg.y);
                    u32x2 wv; wv.x = pk2(y0, y1); wv.y = pk2(y2, y3);
                    *(u32x2*)(REC + ob + 8 * g + 4 * h) = wv;
                }
            }
        }
        __syncthreads();
    }
    if (MODE == 0) {
#pragma unroll
        for (int i = 0; i < 16; ++i) { const size_t o = (size_t)(kt * 32 + crow(i, h)) * 128 + r; SST[o + vt0 * 32] = S0[i]; SST[o + (vt0 + 1) * 32] = S1[i]; }
        if (tg == 0) { SDEC[ch0] = __expf(dsum[0]); SDEC[ch0 + 1] = __expf(dsum[1]); }
    }
}
DI void hgrn_scan_phase(Frame& F) {
    const float* SST = (const float*)(F.ws + WS_SST); float* SIN = (float*)(F.ws + WS_SIN); const float* SDEC = (const float*)(F.ws + WS_SDEC);
    const int gt = F.vcu * NTHR + F.tid, NT = F.G * NTHR;
    for (int q = gt; q < NB * 8 * 4096; q += NT) {
        const int bh = q >> 12, e4 = q & 4095, k = e4 >> 5, v4 = (e4 & 31) * 4;
        const size_t po = (size_t)bh * NSC * (128 * 128) + (size_t)k * 128 + v4; const float* p = SST + po; float* po_ = SIN + po; const float* dp = SDEC + bh * NSC * 128 + k;
        f32x4 R = {0.f, 0.f, 0.f, 0.f};
#pragma unroll 8
        for (int sc = 0; sc < NSC; ++sc) { const f32x4 loc = *(const f32x4*)(p + (size_t)sc * (128 * 128)); const float d = dp[sc * 128]; *(f32x4*)(po_ + (size_t)sc * (128 * 128)) = R; R = R * d + loc; }
    }
}

DI void ld_row_bf16x2(const bf16* a, const bf16* b, int lane, u32x2 (&ra)[4], u32x2 (&rb)[4]) {
#pragma unroll
    for (int j = 0; j < 4; ++j) { ra[j] = *(const u32x2*)(a + 4 * lane + 256 * j); rb[j] = *(const u32x2*)(b + 4 * lane + 256 * j); }
}
DI void ln_resid_phase(Frame& F, const float* g, const float* b) {
    const int gw = F.vcu * NWAVES + F.wave, NGW = F.G * NWAVES, lane = F.lane;
    const bf16* HBA = (const bf16*)(F.ws + WS_HBA); bf16* HB = (bf16*)(F.ws + WS_HB); const bf16* Y16 = (const bf16*)(F.ws + WS_Y16);
    u32x2 ra[4], rb[4];
    if (gw < NTOK) ld_row_bf16x2(HBA + (size_t)gw * DM, Y16 + (size_t)gw * DM, lane, ra, rb);
    for (int m = gw; m < NTOK; m += NGW) {
        f32x4 v[4];
#pragma unroll
        for (int j = 0; j < 4; ++j) { v[j][0] = bflo(ra[j].x) * ALPHA + bflo(rb[j].x); v[j][1] = bfhi(ra[j].x) * ALPHA + bfhi(rb[j].x); v[j][2] = bflo(ra[j].y) * ALPHA + bflo(rb[j].y); v[j][3] = bfhi(ra[j].y) * ALPHA + bfhi(rb[j].y); }
        if (m + NGW < NTOK) ld_row_bf16x2(HBA + (size_t)(m + NGW) * DM, Y16 + (size_t)(m + NGW) * DM, lane, ra, rb);
        ln_row(v, g, b, (float*)nullptr, HB + (size_t)m * DM, F.ws + WS_H8 + (size_t)m * DM, lane);
    }
}

DI void moe_topk_phase(Frame& F, const float* rbias, unsigned* counts) {
    const float* RLOG = (const float*)(F.ws + WS_RLOG); int* TIDX = (int*)(F.ws + WS_TIDX); float* TGATE = (float*)(F.ws + WS_TGATE);
    LAS int* hist = (LAS int*)(F.lds + LDS_KEEP);
    const int lane = F.lane, tid = F.tid, half = lane >> 5;
    const int tpw = (NTOK + F.G - 1) / F.G, t0 = blockIdx.x * tpw, t1 = (t0 + tpw < NTOK) ? t0 + tpw : NTOK;
    if (tid < 256) hist[tid] = 0;
    __syncthreads();
    float bias[4];
#pragma unroll
    for (int j = 0; j < 4; ++j) bias[j] = rbias[lane + 64 * j];
    for (int t = t0 + F.wave; t < t1; t += NWAVES) {
        float sc[4]; unsigned key[4];
#pragma unroll
        for (int j = 0; j < 4; ++j) { sc[j] = 1.f / (1.f + __expf(-RLOG[(size_t)t * 256 + lane + 64 * j])); key[j] = (f2key(sc[j] + bias[j]) & 0xffffff00u) | (unsigned)(255 - (lane + 64 * j)); }
        float gs[8];
#pragma unroll
        for (int j = 0; j < 4; ++j) {
            unsigned a0, a1, b0, b1; half_umax(key[j], a0, a1);
            const unsigned mine = half ? a1 : a0;
            half_umax(key[j] == mine ? 0u : key[j], b0, b1);
            gs[2 * j] = key2f(a0 & 0xffffff00u) + key2f(b0 & 0xffffff00u); gs[2 * j + 1] = key2f(a1 & 0xffffff00u) + key2f(b1 & 0xffffff00u);
        }
        unsigned gsel = 0;
#pragma unroll
        for (int a = 0; a < 8; ++a) { int rank = 0;
#pragma unroll
            for (int q = 0; q < 8; ++q) rank += (gs[q] > gs[a] || (gs[q] == gs[a] && q < a)) ? 1 : 0;
            if (rank < 4) gsel |= 1u << a; }
#pragma unroll
        for (int j = 0; j < 4; ++j) if (!((gsel >> (2 * j + half)) & 1u)) key[j] = 0u;
        int myidx = 0; float mysc = 0.f, ssum = 0.f;
#pragma unroll
        for (int k = 0; k < TOPK; ++k) {
            const unsigned l01 = key[0] > key[1] ? key[0] : key[1], l23 = key[2] > key[3] ? key[2] : key[3];
            const unsigned win = wave_umax(l01 > l23 ? l01 : l23);
            const int e = 255 - (int)(win & 255u), oj = e >> 6, ol = e & 63;
            float s_w;
            const float scj = (oj == 0) ? sc[0] : (oj == 1) ? sc[1] : (oj == 2) ? sc[2] : sc[3];
            s_w = __uint_as_float((unsigned)__builtin_amdgcn_readlane((int)__float_as_uint(scj), ol));
#pragma unroll
            for (int j = 0; j < 4; ++j) if (key[j] == win) key[j] = 0u;
            ssum += s_w;
            if (lane == k) { myidx = e; mysc = s_w; }
        }
        if (lane < TOPK) {
            const int rank = __hip_atomic_fetch_add(&hist[myidx], 1, __ATOMIC_RELAXED, __HIP_MEMORY_SCOPE_WORKGROUP);
            TIDX[(size_t)t * TOPK + lane] = myidx | (rank << 8);
            TGATE[(size_t)t * TOPK + lane] = mysc / ssum * 2.5f;
        }
    }
    __syncthreads();
    if (tid < 256) ((int*)(F.ws + WS_MISC))[4096 + blockIdx.x * 256 + tid] = (int)atomicAdd(&counts[tid], (unsigned)hist[tid]);
}
DI void moe_scatter_phase(Frame& F, const unsigned* counts) {
    const int* TIDX = (const int*)(F.ws + WS_TIDX); int* TPOS = (int*)(F.ws + WS_TPOS); int* ROWTOK = (int*)(F.ws + WS_ROWTOK); int* MISC = (int*)(F.ws + WS_MISC);
    LAS int* hist = (LAS int*)(F.lds + LDS_KEEP); LAS int* wgbase = hist + 256; LAS int* padstart = hist + 512;
    const int tid = F.tid;
    const int tpw = (NTOK + F.G - 1) / F.G, t0 = blockIdx.x * tpw, t1 = (t0 + tpw < NTOK) ? t0 + tpw : NTOK;
    if (tid < 256) { hist[tid] = (int)((__hip_atomic_load(counts + tid, __ATOMIC_RELAXED, __HIP_MEMORY_SCOPE_AGENT) + 255u) & ~255u); wgbase[tid] = MISC[4096 + blockIdx.x * 256 + tid]; }
    __syncthreads();
    if (tid < 256) { int s = 0; for (int e = 0; e < tid; ++e) s += hist[e]; padstart[tid] = s;
        if (blockIdx.x == 0) { for (int tl = s >> 8; tl < (s + hist[tid]) >> 8; ++tl) MISC[tl] = tid; if (tid == 255) MISC[2047] = (s + hist[tid]) >> 8; } }
    __syncthreads();
    for (int i = t0 * TOPK + tid; i < t1 * TOPK; i += NTHR) {
        const int v = TIDX[i], e = v & 255, rank = v >> 8;
        const int pos = padstart[e] + wgbase[e] + rank;
        TPOS[i] = pos; ROWTOK[pos] = i >> 3;
    }
}
DI void moe_combine_phase(Frame& F, const float* g, const float* b, float* outp) {
    const int gw = F.vcu * NWAVES + F.wave, NGW = F.G * NWAVES, lane = F.lane;
    const bf16* HB = (const bf16*)(F.ws + WS_HB); bf16* HBA = (bf16*)(F.ws + WS_HBA); const bf16* Y16 = (const bf16*)(F.ws + WS_Y16);
    const bf16* YS = (const bf16*)(F.ws + WS_YS); const int* TPOS = (const int*)(F.ws + WS_TPOS); const float* TGATE = (const float*)(F.ws + WS_TGATE);
    int pos = 0; float gk = 0.f;
    if (gw < NTOK && lane < TOPK) { pos = TPOS[(size_t)gw * TOPK + lane]; gk = TGATE[(size_t)gw * TOPK + lane]; }
    for (int m = gw; m < NTOK; m += NGW) {
        u32x2 ra[4], rb[4];
        ld_row_bf16x2(HB + (size_t)m * DM, Y16 + (size_t)m * DM, lane, ra, rb);
        u32x2 ys[TOPK][4]; float gate[TOPK];
#pragma unroll
        for (int k = 0; k < TOPK; ++k) { const int pk = __builtin_amdgcn_readlane(pos, k); gate[k] = __uint_as_float((unsigned)__builtin_amdgcn_readlane((int)__float_as_uint(gk), k));
#pragma unroll
            for (int j = 0; j < 4; ++j) ys[k][j] = *(const u32x2*)(YS + (size_t)pk * DM + 4 * lane + 256 * j); }
        if (m + NGW < NTOK && lane < TOPK) { pos = TPOS[(size_t)(m + NGW) * TOPK + lane]; gk = TGATE[(size_t)(m + NGW) * TOPK + lane]; }
        f32x4 v[4];
#pragma unroll
        for (int j = 0; j < 4; ++j) { v[j][0] = bflo(ra[j].x) * ALPHA + bflo(rb[j].x); v[j][1] = bfhi(ra[j].x) * ALPHA + bfhi(rb[j].x); v[j][2] = bflo(ra[j].y) * ALPHA + bflo(rb[j].y); v[j][3] = bfhi(ra[j].y) * ALPHA + bfhi(rb[j].y); }
#pragma unroll
        for (int k = 0; k < TOPK; ++k)
#pragma unroll
            for (int j = 0; j < 4; ++j) { v[j][0] += gate[k] * bflo(ys[k][j].x); v[j][1] += gate[k] * bfhi(ys[k][j].x); v[j][2] += gate[k] * bflo(ys[k][j].y); v[j][3] += gate[k] * bfhi(ys[k][j].y); }
        ln_row(v, g, b, outp ? outp + (size_t)m * DM : (float*)nullptr, outp ? (bf16*)nullptr : HBA + (size_t)m * DM, outp ? (unsigned char*)nullptr : F.ws + WS_H8 + (size_t)m * DM, lane);
    }
}

constexpr int PH_PER_LAYER = 13, N_PHASES = 1 + 2 * PH_PER_LAYER;
__global__ void __launch_bounds__(NTHR, 2) fwd_kernel(Args args) {
    extern __shared__ __attribute__((aligned(16))) unsigned char lds[];
    Frame F;
    F.lds = (LAS unsigned char*)lds;
    F.tid = threadIdx.x; F.lane = F.tid & 63; F.wave = __builtin_amdgcn_readfirstlane(F.tid >> 6);
    F.G = gridDim.x; { const int bx = blockIdx.x; F.vcu = (F.G % 8 == 0) ? (bx % 8) * (F.G / 8) + bx / 8 : bx; }
    F.ws = args.ws;
    unsigned* ctl = (unsigned*)(F.ws + WS_CTL);
    volatile LAS unsigned* MISCW = (volatile LAS unsigned*)(F.lds + MISC_OFF);
    if (F.tid < 32) MISCW[F.tid] = 0u;
    __syncthreads();
    const int lo = args.ph_lo, hi = args.ph_hi;
    XcdBarrier bar; bar.bar = ctl + CW_BAR; bar.x = 0; bar.st = MISCW + 8;
    if (hi - lo > 1) bar = xcd_barrier_post(ctl + CW_BAR, MISCW + 8);
#define IN(k) (lo <= (k) && (k) < hi)
#if defined(PROBE_A)
    unsigned long long t_prev = __builtin_amdgcn_s_memrealtime();
#define PROBE_STAMP(k) do { if (blockIdx.x == 0 && threadIdx.x == 0) { const unsigned long long t_now = __builtin_amdgcn_s_memrealtime(); const unsigned dt = (unsigned)(t_now - t_prev); t_prev = t_now; \
        if ((k) == PROBE_A) __hip_atomic_store(ctl + 8, dt, __ATOMIC_RELAXED, __HIP_MEMORY_SCOPE_AGENT); if ((k) == PROBE_B) __hip_atomic_store(ctl + 9, dt, __ATOMIC_RELAXED, __HIP_MEMORY_SCOPE_AGENT); } } while (0)
#else
#define PROBE_STAMP(k) do { } while (0)
#endif
#define SEAM(k) do { if (IN(k) && IN((k) + 1)) xcd_barrier(bar); PROBE_STAMP(k); } while (0)
#if defined(REP_K)
#define PH_REP(k) for (int _rep = 0, _n = ((k) == REP_K ? REP_N : 1); _rep < _n; ++_rep, (_rep < _n ? xcd_barrier(bar) : (void)0))
#else
#define PH_REP(k)
#endif

    if (IN(0)) PH_REP(0) { prologue(F, args); }
    SEAM(0);

#define PHASE_ENTER() do { F.ws = opaque_ptr(args.ws); F.tid = opaque_v(threadIdx.x); F.lane = F.tid & 63; F.wave = __builtin_amdgcn_readfirstlane(F.tid >> 6); } while (0)
    enum { P_INPROJ = 0, P_MIX_A, P_SCAN, P_MIX_C, P_PROJ, P_WOUT, P_LN1, P_ROUTER, P_TOPK, P_SCATTER, P_EXP_GU, P_EXP_DOWN, P_COMBINE };
    static_assert(P_COMBINE + 1 == PH_PER_LAYER, "phase count");
    for (int l = 0; l < 2; ++l) {
        const int pb = 1 + PH_PER_LAYER * l;
        if (IN(pb + P_INPROJ)) PH_REP(pb + P_INPROJ) { PHASE_ENTER();
            pg8::DenseSched S{(const bf16*)(F.ws + WS_H8), (const bf16*)(F.ws + WS_WIN) + (size_t)l * (INW * 512), 512, NTOK / 256, INW / 256, F.G, (int)blockIdx.x};
            pg8::EpiInProj E{F.ws, args.in[I_BIN] + (size_t)l * INW, (const float*)(F.ws + WS_LB) + l * 1024};
            pg8::gemm_phase<true>(F.lds, S, E, 0x79797979, 0x7f7f7f7f);
        }
        SEAM(pb + P_INPROJ);
        if (IN(pb + P_MIX_A)) PH_REP(pb + P_MIX_A) { PHASE_ENTER();
            for (int u = F.vcu; u < NB * NCHUNK * 4; u += F.G) { const int hk = u & 3, c = (u >> 2) % NCHUNK, b = u / (4 * NCHUNK); attn_unit(F, b, c, hk, args.in[I_SINK] + l * 16); }
            for (int u = F.vcu; u < NB * 8 * NSC; u += F.G) { const int sc = u % NSC, bh = u / NSC; hgrn_unit<0>(F, bh >> 3, bh & 7, sc, nullptr); }
        }
        SEAM(pb + P_MIX_A);
        if (IN(pb + P_SCAN)) PH_REP(pb + P_SCAN) { PHASE_ENTER(); hgrn_scan_phase(F); }
        SEAM(pb + P_SCAN);
        if (IN(pb + P_MIX_C)) PH_REP(pb + P_MIX_C) { PHASE_ENTER();
            for (int u = F.vcu; u < NB * 8 * NSC; u += F.G) { const int sc = u % NSC, bh = u / NSC; hgrn_unit<1>(F, bh >> 3, bh & 7, sc, args.in[I_RNG] + l * 128); }
        }
        SEAM(pb + P_MIX_C);
        if (IN(pb + P_PROJ)) PH_REP(pb + P_PROJ) { PHASE_ENTER();
            { pg8::DenseSched S{(const bf16*)(F.ws + WS_ATT), (const bf16*)(F.ws + WS_WPA) + (size_t)l * (1024 * 1024), 1024, NTOK / 256, 4, F.G, (int)blockIdx.x};
              pg8::EpiGate<false> E{(bf16*)(F.ws + WS_MRG), (const bf16*)(F.ws + WS_GA)}; pg8::gemm_phase(F.lds, S, E); }
            { pg8::DenseSched S{(const bf16*)(F.ws + WS_REC), (const bf16*)(F.ws + WS_WPR) + (size_t)l * (1024 * 1024), 1024, NTOK / 256, 4, F.G, (int)blockIdx.x};
              pg8::EpiGate<true> E{(bf16*)(F.ws + WS_MRG), (const bf16*)(F.ws + WS_GT)}; pg8::gemm_phase(F.lds, S, E); }
        }
        SEAM(pb + P_PROJ);
        if (IN(pb + P_WOUT)) PH_REP(pb + P_WOUT) { PHASE_ENTER();
            pg8::DenseSched S{(const bf16*)(F.ws + WS_MRG), (const bf16*)(F.ws + WS_WOUT) + (size_t)l * (1024 * 1024), 1024, NTOK / 256, 4, F.G, (int)blockIdx.x};
            pg8::EpiBf16 E{(bf16*)(F.ws + WS_Y16), 1024}; pg8::gemm_phase(F.lds, S, E);
        }
        SEAM(pb + P_WOUT);
        if (IN(pb + P_LN1)) PH_REP(pb + P_LN1) { PHASE_ENTER(); ln_resid_phase(F, args.in[I_LN1G] + l * 1024, args.in[I_LN1B] + l * 1024); }
        SEAM(pb + P_LN1);
        if (IN(pb + P_ROUTER)) PH_REP(pb + P_ROUTER) { PHASE_ENTER();
            pg8::DenseSched S{(const bf16*)(F.ws + WS_HB), (const bf16*)(F.ws + WS_WRS) + (size_t)l * (768 * 1024), 1024, NTOK / 256, 3, F.G, (int)blockIdx.x};
            pg8::EpiRouterShared E{(float*)(F.ws + WS_RLOG), (bf16*)(F.ws + WS_SACT)}; pg8::gemm_phase(F.lds, S, E);
        }
        SEAM(pb + P_ROUTER);
        if (IN(pb + P_TOPK)) PH_REP(pb + P_TOPK) { PHASE_ENTER(); moe_topk_phase(F, args.in[I_RB] + l * 256, (unsigned*)(F.ws + WS_CTL) + CW_CNT + l * 256); }
        SEAM(pb + P_TOPK);
        if (IN(pb + P_SCATTER)) PH_REP(pb + P_SCATTER) { PHASE_ENTER(); moe_scatter_phase(F, (unsigned*)(F.ws + WS_CTL) + CW_CNT + l * 256); }
        SEAM(pb + P_SCATTER);
        if (IN(pb + P_EXP_GU)) PH_REP(pb + P_EXP_GU) { PHASE_ENTER();
            const int* MISC = (const int*)(F.ws + WS_MISC); const int ntiles = __builtin_amdgcn_readfirstlane(MISC[2047]);
            { pg8::GroupSched<true> S{(const bf16*)(F.ws + WS_H8), (const bf16*)(F.ws + WS_WEGU) + (size_t)l * 256 * (512 * 512), (const int*)(F.ws + WS_ROWTOK), MISC, 512, ntiles, 2, F.G, (int)blockIdx.x, (size_t)512 * 512};
              pg8::EpiSwigluF8 E{F.ws + WS_ACT, 256}; pg8::gemm_phase<true>(F.lds, S, E, 0x79797979, 0x7f7f7f7f); }
            { pg8::DenseSched S{(const bf16*)(F.ws + WS_SACT), (const bf16*)(F.ws + WS_WSD) + (size_t)l * (1024 * 256), 256, NTOK / 256, 4, F.G, (int)blockIdx.x};
              pg8::EpiBf16 E{(bf16*)(F.ws + WS_Y16), 1024}; pg8::gemm_phase(F.lds, S, E); }
        }
        SEAM(pb + P_EXP_GU);
        if (IN(pb + P_EXP_DOWN)) PH_REP(pb + P_EXP_DOWN) { PHASE_ENTER();
            const int* MISC = (const int*)(F.ws + WS_MISC); const int ntiles = __builtin_amdgcn_readfirstlane(MISC[2047]);
            pg8::GroupSched<false> S{(const bf16*)(F.ws + WS_ACT), (const bf16*)(F.ws + WS_WED) + (size_t)l * 256 * (1024 * 128), nullptr, MISC, 128, ntiles, 4, F.G, (int)blockIdx.x, (size_t)1024 * 128};
            pg8::EpiBf16 E{(bf16*)(F.ws + WS_YS), 1024}; pg8::gemm_phase<true>(F.lds, S, E, 0x79797979, 0x7c7c7c7c);
        }
        SEAM(pb + P_EXP_DOWN);
        if (IN(pb + P_COMBINE)) PH_REP(pb + P_COMBINE) { PHASE_ENTER(); moe_combine_phase(F, args.in[I_LN2G] + l * 1024, args.in[I_LN2B] + l * 1024, l == 1 ? args.out : (float*)nullptr); }
        if (l == 0) SEAM(pb + P_COMBINE);
    }
#if defined(PROBE_A)
    xcd_barrier(bar); PROBE_STAMP(N_PHASES - 1);
    xcd_barrier(bar);
    {   const float ta = (float)__hip_atomic_load(ctl + 8, __ATOMIC_RELAXED, __HIP_MEMORY_SCOPE_AGENT) * 0.01f, tb = (float)__hip_atomic_load(ctl + 9, __ATOMIC_RELAXED, __HIP_MEMORY_SCOPE_AGENT) * 0.01f;
        const float va = sqrtf(ta);
        for (size_t i = (size_t)blockIdx.x * NTHR + threadIdx.x; i < (size_t)NTOK * DM; i += (size_t)gridDim.x * NTHR) args.out[i] = (i == 0) ? (100.f + tb) : va; }
#endif
#undef IN
#undef SEAM
}

#ifndef MK_PER_PHASE
#define MK_PER_PHASE 0
#endif
extern "C" void kernel_launch(void* const* d_in, const int* in_sizes, int n_in, void* d_out, int out_size, void* d_ws, size_t ws_size, hipStream_t stream) {
    static int grid = 0;
    if (grid == 0) {
        if (n_in != 21 || out_size != NTOK * DM || ws_size < WS_END) { fprintf(stderr, "kernel_launch: unexpected shapes (n_in %d out %d ws %zu)\n", n_in, out_size, ws_size); grid = -1; return; }
        int dev = 0, cus = 0, per_cu = 0;
        if (hipGetDevice(&dev) != hipSuccess || hipDeviceGetAttribute(&cus, hipDeviceAttributeMultiprocessorCount, dev) != hipSuccess) { grid = -1; return; }
        if (hipFuncSetAttribute((const void*)fwd_kernel, hipFuncAttributeMaxDynamicSharedMemorySize, LDS_BYTES) != hipSuccess) { fprintf(stderr, "kernel_launch: hipFuncSetAttribute failed\n"); grid = -1; return; }
        if (hipOccupancyMaxActiveBlocksPerMultiprocessor(&per_cu, (const void*)fwd_kernel, NTHR, LDS_BYTES) != hipSuccess || per_cu < 1) { fprintf(stderr, "kernel_launch: occupancy query says %d\n", per_cu); }
        (void)hipGetLastError();
        grid = cus;
    }
    if (grid < 0) return;
    (void)hipMemsetAsync((char*)d_ws + WS_CTL, 0, CTL_ZERO_BYTES, stream);
    Args a{};
    for (int i = 0; i < 21; ++i) a.in[i] = (const float*)d_in[i];
    a.out = (float*)d_out; a.ws = (unsigned char*)d_ws;
#if MK_PER_PHASE
    for (int p = 0; p < N_PHASES; ++p) { a.ph_lo = p; a.ph_hi = p + 1; hipLaunchKernelGGL(fwd_kernel, dim3(grid), dim3(NTHR), LDS_BYTES, stream, a); }
#else
    a.ph_lo = 0; a.ph_hi = N_PHASES; hipLaunchKernelGGL(fwd_kernel, dim3(grid), dim3(NTHR), LDS_BYTES, stream, a);
#endif
}
```
